# Optimizing an MI355X kernel written in HIP

```python
import jax
import jax.numpy as jnp
from jax import lax
import numpy as np


D_MODEL = 2048
BATCH = 16
SEQ = 2048
DEPTH = 2

HEAD_DIM = 128
DIL_CONFIGS = ((128, 1), (512, 4), (2048, 16))
N_GROUPS_A = len(DIL_CONFIGS)
HEADS_PER_GROUP_A = 8
WIDTH_A = HEADS_PER_GROUP_A * HEAD_DIM
N_HEADS_B = D_MODEL // HEAD_DIM
WIDTH_B = N_HEADS_B * HEAD_DIM
ROT_DIM = HEAD_DIM // 4
ROPE_THETA = 500000.0
D_FF = ((8 * D_MODEL + 3 * 256 - 1) // (3 * 256)) * 256
BLOCK = 128
N_A_LAYERS = DEPTH // 2
N_B_LAYERS = DEPTH - N_A_LAYERS
EPS = 1e-6
NEG_INF = -1e30

kernel_name = 'yoco_dilated_fox_hybrid'


def rmsnorm(x, g):
    xf = x.astype(jnp.float32)
    y = xf * lax.rsqrt(jnp.mean(xf * xf, axis=-1, keepdims=True) + EPS)
    return (y * g.astype(jnp.float32)).astype(x.dtype)


def modulate(h, shift, scale):
    return h * (1.0 + scale[:, None, :]) + shift[:, None, :]


def swiglu(h, w_in, w_out):
    g, u = jnp.split(h @ w_in, 2, axis=-1)
    return (jax.nn.silu(g) * u) @ w_out


def rope_tables(seq):
    inv = ROPE_THETA ** (-jnp.arange(0, ROT_DIM, 2, dtype=jnp.float32) / ROT_DIM)
    ang = jnp.arange(seq, dtype=jnp.float32)[:, None] * inv[None, :]
    return jnp.cos(ang), jnp.sin(ang)


def partial_rope(x, cos, sin):
    half = ROT_DIM // 2
    shape = (1, x.shape[1]) + (1,) * (x.ndim - 3) + (half,)
    cos = cos.reshape(shape).astype(x.dtype)
    sin = sin.reshape(shape).astype(x.dtype)
    x1 = x[..., :half]
    x2 = x[..., half:ROT_DIM]
    return jnp.concatenate([x1 * cos - x2 * sin, x2 * cos + x1 * sin, x[..., ROT_DIM:]], axis=-1)


def dilated_group_attention(q, k, v, window, dilation):
    b, s, h, dh = q.shape
    n_back = window // dilation
    sub_len = s // dilation
    nb = -(-sub_len // BLOCK)
    pad = nb * BLOCK - sub_len

    def to_blocks(t):
        t = t.reshape(b, sub_len, dilation, h, dh)
        t = jnp.pad(t, ((0, 0), (0, pad), (0, 0), (0, 0), (0, 0)))
        return t.reshape(b, nb, BLOCK, dilation, h, dh)

    def with_prev(t):
        prev = jnp.pad(t[:, :-1], ((0, 0), (1, 0), (0, 0), (0, 0), (0, 0), (0, 0)))
        return jnp.concatenate([prev, t], axis=2)

    qb = to_blocks(q)
    kb = with_prev(to_blocks(k))
    vb = with_prev(to_blocks(v))
    scores = jnp.einsum('bnqrhd,bnkrhd->bnrhqk', qb, kb,
                        preferred_element_type=jnp.float32) * (dh ** -0.5)
    qi = jnp.arange(BLOCK)[:, None]
    kj = jnp.arange(2 * BLOCK)[None, :]
    dist = qi + BLOCK - kj
    band = (dist >= 0) & (dist <= n_back)
    exists = (jnp.arange(nb)[:, None, None] > 0) | (kj >= BLOCK)[None]
    mask = band[None] & exists
    scores = jnp.where(mask[None, :, None, None], scores, NEG_INF)
    m = jnp.max(scores, axis=-1, keepdims=True)
    p = jnp.exp(scores - m)
    den = jnp.sum(p, axis=-1)
    o = jnp.einsum('bnrhqk,bnkrhd->bnqrhd', p.astype(v.dtype), vb,
                   preferred_element_type=jnp.float32)
    o = o / jnp.transpose(den, (0, 1, 4, 2, 3))[..., None]
    lse = jnp.transpose(m[..., 0] + jnp.log(den), (0, 1, 4, 2, 3))
    o = o.reshape(b, nb * BLOCK, dilation, h, dh)[:, :sub_len].reshape(b, s, h, dh)
    lse = lse.reshape(b, nb * BLOCK, dilation, h)[:, :sub_len].reshape(b, s, h)
    return o, lse


def dilated_mixture_attention(h, w_qkv, g_q, g_k, w_o, cos, sin):
    b, s, _ = h.shape
    qkv = (h @ w_qkv).reshape(b, s, 3, N_GROUPS_A, HEADS_PER_GROUP_A, HEAD_DIM)
    q = partial_rope(rmsnorm(qkv[:, :, 0], g_q[:, None, :]), cos, sin)
    k = partial_rope(rmsnorm(qkv[:, :, 1], g_k[:, None, :]), cos, sin)
    v = qkv[:, :, 2]
    outs, lses = [], []
    for gi, (window, dilation) in enumerate(DIL_CONFIGS):
        o, l = dilated_group_attention(q[:, :, gi], k[:, :, gi], v[:, :, gi], window, dilation)
        outs.append(o)
        lses.append(l)
    alpha = jax.nn.softmax(jnp.stack(lses), axis=0)
    o = jnp.sum(alpha[..., None] * jnp.stack(outs), axis=0)
    return o.astype(h.dtype).reshape(b, s, WIDTH_A) @ w_o


def shared_kv(x, mod_kv, g_norm_kv, w_kv, g_k, w_f, b_f):
    b, s, _ = x.shape
    shift, scale = jnp.split(mod_kv, 2, axis=-1)
    h = modulate(rmsnorm(x, g_norm_kv), shift, scale)
    kv = (h @ w_kv).reshape(b, s, 2, N_HEADS_B, HEAD_DIM)
    k = rmsnorm(kv[:, :, 0], g_k)
    v = kv[:, :, 1]
    log_f = jax.nn.log_sigmoid((h @ w_f + b_f).astype(jnp.float32))
    cum_log_f = jnp.cumsum(log_f, axis=1)
    return k, v, cum_log_f


def forgetting_attention(h, w_q, g_q, w_o, k, v, cum_log_f):
    b, s, _ = h.shape
    nb = s // BLOCK
    q = rmsnorm((h @ w_q).reshape(b, s, N_HEADS_B, HEAD_DIM), g_q)
    q_blocks = jnp.moveaxis(q.reshape(b, nb, BLOCK, N_HEADS_B, HEAD_DIM), 1, 0)
    fq_blocks = jnp.moveaxis(cum_log_f.reshape(b, nb, BLOCK, N_HEADS_B), 1, 0)
    fk = jnp.transpose(cum_log_f, (0, 2, 1))
    key_pos = jnp.arange(s)
    scale = HEAD_DIM ** -0.5

    def attend_block(args):
        q_blk, fq, blk = args
        logits = jnp.einsum('bqhd,bkhd->bhqk', q_blk, k,
                            preferred_element_type=jnp.float32) * scale
        logits = logits + jnp.transpose(fq, (0, 2, 1))[..., None] - fk[:, :, None, :]
        q_pos = blk * BLOCK + jnp.arange(BLOCK)
        logits = jnp.where(key_pos[None, :] <= q_pos[:, None], logits, NEG_INF)
        p = jax.nn.softmax(logits, axis=-1)
        return jnp.einsum('bhqk,bkhd->bqhd', p.astype(v.dtype), v)

    o = lax.map(attend_block, (q_blocks, fq_blocks, jnp.arange(nb)))
    o = jnp.moveaxis(o, 0, 1).reshape(b, s, WIDTH_B)
    return o @ w_o


def setup_inputs(seed: int = 0) -> dict:
    key = jax.random.key(seed)
    ks = jax.random.split(key, 24)

    def nrm(k, shape, scale):
        return jax.random.normal(k, shape, jnp.float32) * scale

    def gain(k, shape):
        return 1.0 + 0.02 * jax.random.normal(k, shape, jnp.float32)

    d = D_MODEL
    return {
        'x': nrm(ks[0], (BATCH, SEQ, d), 1.0),
        'c': nrm(ks[1], (BATCH, d), 1.0),
        'w_ada': nrm(ks[2], (DEPTH, d, 6 * d), 0.5 * d ** -0.5),
        'b_ada': nrm(ks[3], (DEPTH, 6 * d), 0.02),
        'g_norm_attn': gain(ks[4], (DEPTH, d)),
        'g_norm_ffn': gain(ks[5], (DEPTH, d)),
        'w_qkv_a': nrm(ks[6], (N_A_LAYERS, d, 3 * N_GROUPS_A * WIDTH_A), d ** -0.5),
        'g_qk_a': gain(ks[7], (N_A_LAYERS, 2, N_GROUPS_A, HEAD_DIM)),
        'w_o_a': nrm(ks[8], (N_A_LAYERS, WIDTH_A, d), WIDTH_A ** -0.5),
        'w_ada_kv': nrm(ks[9], (d, 2 * d), 0.5 * d ** -0.5),
        'b_ada_kv': nrm(ks[10], (2 * d,), 0.02),
        'g_norm_kv': gain(ks[11], (d,)),
        'w_kv': nrm(ks[12], (d, 2 * WIDTH_B), d ** -0.5),
        'g_k_b': gain(ks[13], (HEAD_DIM,)),
        'w_f': nrm(ks[14], (d, N_HEADS_B), 0.5 * d ** -0.5),
        'b_f': jax.random.uniform(ks[15], (N_HEADS_B,), jnp.float32, 1.0, 5.0),
        'w_q_b': nrm(ks[16], (N_B_LAYERS, d, WIDTH_B), d ** -0.5),
        'g_q_b': gain(ks[17], (N_B_LAYERS, HEAD_DIM)),
        'w_o_b': nrm(ks[18], (N_B_LAYERS, WIDTH_B, d), WIDTH_B ** -0.5),
        'w_ffn_in': nrm(ks[19], (DEPTH, d, 2 * D_FF), d ** -0.5),
        'w_ffn_out': nrm(ks[20], (DEPTH, D_FF, d), D_FF ** -0.5),
    }


def reference(x, c, w_ada, b_ada, g_norm_attn, g_norm_ffn, w_qkv_a, g_qk_a, w_o_a,
              w_ada_kv, b_ada_kv, g_norm_kv, w_kv, g_k_b, w_f, b_f, w_q_b, g_q_b, w_o_b,
              w_ffn_in, w_ffn_out):
    s = x.shape[1]
    cos, sin = rope_tables(s)
    c_act = jax.nn.silu(c)
    k_sh = None
    v_sh = None
    f_sh = None
    for layer in range(DEPTH):
        mods = c_act @ w_ada[layer] + b_ada[layer]
        sh_a, sc_a, gt_a, sh_f, sc_f, gt_f = jnp.split(mods, 6, axis=-1)
        h = modulate(rmsnorm(x, g_norm_attn[layer]), sh_a, sc_a)
        if layer < N_A_LAYERS:
            i = layer
            y = dilated_mixture_attention(h, w_qkv_a[i], g_qk_a[i, 0], g_qk_a[i, 1],
                                          w_o_a[i], cos, sin)
        else:
            i = layer - N_A_LAYERS
            y = forgetting_attention(h, w_q_b[i], g_q_b[i], w_o_b[i], k_sh, v_sh, f_sh)
        x = x + gt_a[:, None, :] * y
        h = modulate(rmsnorm(x, g_norm_ffn[layer]), sh_f, sc_f)
        x = x + gt_f[:, None, :] * swiglu(h, w_ffn_in[layer], w_ffn_out[layer])
        if layer == N_A_LAYERS - 1:
            mod_kv = c_act @ w_ada_kv + b_ada_kv
            k_sh, v_sh, f_sh = shared_kv(x, mod_kv, g_norm_kv, w_kv, g_k_b, w_f, b_f)
    return x
```

```cpp
#include <hip/hip_runtime.h>
#include <hip/hip_cooperative_groups.h>
#include <cstdio>
#include <cstdint>
namespace cg = cooperative_groups;
namespace pg8 {
#define PG8_LAS __attribute__((address_space(3)))
typedef unsigned short bf16_t;
typedef short bf16x8 __attribute__((ext_vector_type(8)));
typedef float f32x4 __attribute__((ext_vector_type(4)));
typedef unsigned u32x4 __attribute__((ext_vector_type(4)));
constexpr int BM = 256, BK = 64, HALF = 128, HTB = HALF * BK * 2  , STAGE_BYTES = 8 * HTB, NXCD = 8, WGM = 8;

__host__ __device__ __forceinline__ int lds_byte(int r, int c) { const int st = (r >> 4) * 2 + (c >> 5), rr = r & 15, cc = c & 31, ob = rr * 64 + cc * 2; return st * 1024 + (ob ^ (((ob >> 9) & 1) << 5)); }
__host__ __device__ __forceinline__ void stage_rc(int b, int& R, int& C) { const int st = b / 1024, sb = b % 1024, swz = sb ^ (((sb >> 9) & 1) << 5); R = (st >> 1) * 16 + swz / 64; C = (st & 1) * 32 + (swz % 64) / 2; }
__host__ __device__ __forceinline__ int perm32(int rho) { const int n = rho >> 4, i = rho & 15; return 8 * (i >> 2) + 4 * n + (i & 3); }

struct Unit { int pm, pn; };
struct Gemm { const bf16_t* A; const bf16_t* Bt; int M, N, K; };

struct StaticOrder {
    int nM, nN, nwg, G, c;
    __host__ __device__ void init(int M, int N, int G_, int c_) { nM = M / BM; nN = N / BM; nwg = nM * nN; G = G_; c = c_; }
    __host__ __device__ bool next(int i, Unit& u) const {
        const long L = (long)i * G + c; if (L >= nwg) return false;
        int wgid = (int)L; { const int q = nwg / NXCD, r = nwg % NXCD, xcd = wgid % NXCD, off = wgid / NXCD; wgid = (xcd < r ? xcd * (q + 1) : r * (q + 1) + (xcd - r) * q) + off; }
        const int nig = WGM * nN, gid = wgid / nig, fm = gid * WGM, gsz = (nM - fm) < WGM ? (nM - fm) : WGM;
        u.pm = fm + ((wgid % nig) % gsz); u.pn = (wgid % nig) / gsz; return true;
    }
    __device__ __forceinline__ void a_ready(const Unit&) const {}
    __device__ __forceinline__ void done(const Unit&) const {}
};

__device__ __forceinline__ unsigned cvt_pk_bf16(float lo, float hi) { unsigned r; asm volatile("v_cvt_pk_bf16_f32 %0, %1, %2" : "=v"(r) : "v"(lo), "v"(hi)); return r; }
struct EpiStore {
    static constexpr bool PERM = true, AFTER_DRAIN = false;
    bf16_t* O; int ldc; int ftile; float* logf; const float* bf;
    __device__ __forceinline__ void operator()(const f32x4 (&acc)[2][2][4][2], const Unit& u, int wr, int wc, int fr, int fq) const {
        const int row0 = u.pm * BM + wr * 64 + fr;
        if (u.pn >= ftile) {
            if (wc == 0 && fq < 2) {
#pragma unroll
                for (int ai = 0; ai < 2; ++ai)
#pragma unroll
                    for (int m = 0; m < 4; ++m) { float* rp = logf + (size_t)(row0 + ai * HALF + m * 16) * 16 + 8 * fq;
#pragma unroll
                        for (int n = 0; n < 2; ++n) { f32x4 z = acc[ai][0][m][n], o;
#pragma unroll
                            for (int j = 0; j < 4; ++j) { const float zz = z[j] + bf[8 * fq + 4 * n + j]; o[j] = fminf(zz, 0.f) - log1pf(__expf(-fabsf(zz))); }
                            *(f32x4*)(rp + 4 * n) = o; } }
            }
            return;
        }
        const int col0 = u.pn * BM + wc * 32 + 8 * fq;
#pragma unroll
        for (int ai = 0; ai < 2; ++ai)
#pragma unroll
            for (int m = 0; m < 4; ++m) { bf16_t* rowp = O + (size_t)(row0 + ai * HALF + m * 16) * ldc + col0;
#pragma unroll
                for (int bj = 0; bj < 2; ++bj) { const f32x4 v0 = acc[ai][bj][m][0], v1 = acc[ai][bj][m][1];
                    u32x4 w; w.x = cvt_pk_bf16(v0[0], v0[1]); w.y = cvt_pk_bf16(v0[2], v0[3]); w.z = cvt_pk_bf16(v1[0], v1[1]); w.w = cvt_pk_bf16(v1[2], v1[3]);
                    *(u32x4*)(rowp + bj * HALF) = w; } }
    }
};
struct EpiSwiglu {
    static constexpr bool PERM = true, AFTER_DRAIN = false;
    bf16_t* O; int ldc;
    __device__ __forceinline__ void operator()(const f32x4 (&acc)[2][2][4][2], const Unit& u, int wr, int wc, int fr, int fq) const {
        const int row0 = u.pm * BM + wr * 64 + fr, col0 = u.pn * HALF + wc * 32 + 8 * fq;
#pragma unroll
        for (int ai = 0; ai < 2; ++ai)
#pragma unroll
            for (int m = 0; m < 4; ++m) { bf16_t* rowp = O + (size_t)(row0 + ai * HALF + m * 16) * ldc + col0; float r[8];
#pragma unroll
                for (int n = 0; n < 2; ++n)
#pragma unroll
                    for (int j = 0; j < 4; ++j) { const float g = acc[ai][0][m][n][j], up = acc[ai][1][m][n][j];
                        r[4 * n + j] = g * __builtin_amdgcn_rcpf(1.f + __builtin_amdgcn_exp2f(-1.4426950408889634f * g)) * up; }
                u32x4 w; w.x = cvt_pk_bf16(r[0], r[1]); w.y = cvt_pk_bf16(r[2], r[3]); w.z = cvt_pk_bf16(r[4], r[5]); w.w = cvt_pk_bf16(r[6], r[7]);
                *(u32x4*)rowp = w; }
    }
};
struct EpiResid {
    static constexpr bool PERM = false, AFTER_DRAIN = false;
    const float* base; float* out; int ldc; const float* gate; int gpitch;
    __device__ __forceinline__ void operator()(const f32x4 (&acc)[2][2][4][2], const Unit& u, int wr, int wc, int fr, int fq) const {
        const int row0 = u.pm * BM + wr * 64 + fr, col0 = u.pn * BM + wc * 32 + 4 * fq;
        const float* gp = gate + (size_t)(u.pm >> 3) * gpitch + col0;
        f32x4 gv[2][2];
#pragma unroll
        for (int bj = 0; bj < 2; ++bj)
#pragma unroll
            for (int n = 0; n < 2; ++n) gv[bj][n] = *(const f32x4*)(gp + bj * HALF + n * 16);
#pragma unroll
        for (int ai = 0; ai < 2; ++ai)
#pragma unroll
            for (int m = 0; m < 4; ++m) { const size_t off = (size_t)(row0 + ai * HALF + m * 16) * ldc + col0;
#pragma unroll
                for (int bj = 0; bj < 2; ++bj)
#pragma unroll
                    for (int n = 0; n < 2; ++n) { const f32x4 bs = *(const f32x4*)(base + off + bj * HALF + n * 16);
                        *(f32x4*)(out + off + bj * HALF + n * 16) = bs + gv[bj][n] * acc[ai][bj][m][n]; } }
    }
};
template <class Epi, class Sched, bool ALIGN_EPI = false, bool SP2 = false>
__device__ __forceinline__ void gemm_phase(PG8_LAS unsigned char* lds, const Gemm g, const Sched& S, const Epi& E) {
    const int tid = threadIdx.x, wid = __builtin_amdgcn_readfirstlane(tid >> 6), lane = tid & 63, wr = wid >> 2, wc = wid & 3, fr = lane & 15, fq = lane >> 4;
    const int K = g.K, nt = K / BK;
    unsigned voffA[2], voffB[2];
#pragma unroll
    for (int i = 0; i < 2; ++i) { int R, C; stage_rc(tid * 16 + i * 8192, R, C); const int Rb = Epi::PERM ? ((R & ~31) + perm32(R & 31)) : R;
        voffA[i] = (unsigned)(R * K + C) * 2u; voffB[i] = (unsigned)(Rb * K + C) * 2u; }
    const size_t kstep = (size_t)(BK * 2);
    const size_t hstep = (size_t)HALF * K * 2;
    const size_t tstep = 2 * hstep;
    const unsigned ldsw = (unsigned)wid * 1024u;
    const int aoff = lds_byte(wr * 64 + fr, fq * 8), boff = lds_byte(wc * 32 + fr, fq * 8);
#define PG8_SA(b, h) (((b) * 2 + (h)) * HTB)
#define PG8_SB(b, h) ((4 + (b) * 2 + (h)) * HTB)
#define PG8_STAGE(bufoff, gbase, voff) do { _Pragma("unroll") for (int _i = 0; _i < 2; ++_i) \
        __builtin_amdgcn_global_load_lds((const unsigned*)((const char*)(gbase) + (voff)[_i]), (PG8_LAS unsigned*)(lds + (bufoff) + ldsw + _i * 8192), 16, 0, 0); } while (0)
#define PG8_LDA(dst, b, h) do { _Pragma("unroll") for (int m = 0; m < 4; ++m) _Pragma("unroll") for (int k = 0; k < 2; ++k) dst[m][k] = *(const PG8_LAS bf16x8*)(lds + PG8_SA(b, h) + aoff + m * 2048 + k * 1024); } while (0)
#define PG8_LDB(dst, b, h) do { _Pragma("unroll") for (int n = 0; n < 2; ++n) _Pragma("unroll") for (int k = 0; k < 2; ++k) dst[n][k] = *(const PG8_LAS bf16x8*)(lds + PG8_SB(b, h) + boff + n * 2048 + k * 1024); } while (0)
#define PG8_MMA(ai, bj, At, Bt) do { __builtin_amdgcn_s_setprio(1); _Pragma("unroll") for (int m = 0; m < 4; ++m) _Pragma("unroll") for (int n = 0; n < 2; ++n) _Pragma("unroll") for (int k = 0; k < 2; ++k) \
        acc[ai][bj][m][n] = __builtin_amdgcn_mfma_f32_16x16x32_bf16(Bt[n][k], At[m][k], acc[ai][bj][m][n], 0, 0, 0); __builtin_amdgcn_s_setprio(0); } while (0)
#define PG8_WAIT_V(n) asm volatile("s_waitcnt vmcnt(" #n ")" ::: "memory")
#define PG8_WAIT_L(n) asm volatile("s_waitcnt lgkmcnt(" #n ")" ::: "memory")
#define PG8_BAR __builtin_amdgcn_s_barrier()
#define PG8_SCHED __builtin_amdgcn_sched_barrier(0)
    Unit cur, nxt; int ui = 0;
    if (!S.next(0, cur)) return;
    f32x4 acc[2][2][4][2];
#pragma unroll
    for (int a = 0; a < 2; ++a)
#pragma unroll
        for (int b = 0; b < 2; ++b)
#pragma unroll
            for (int m = 0; m < 4; ++m)
#pragma unroll
                for (int n = 0; n < 2; ++n) acc[a][b][m][n] = (f32x4){0.f, 0.f, 0.f, 0.f};
    bf16x8 At[4][2], B0[2][2], B1[2][2];
    const char* cA = (const char*)g.A + (size_t)cur.pm * tstep; const char* cB = (const char*)g.Bt + (size_t)cur.pn * tstep;
    S.a_ready(cur);
    if constexpr (SP2) {
        PG8_STAGE(PG8_SB(0, 0), cB, voffB); PG8_STAGE(PG8_SB(0, 1), cB + hstep, voffB); PG8_STAGE(PG8_SA(0, 0), cA, voffA); PG8_STAGE(PG8_SA(0, 1), cA + hstep, voffA);
        if (wr == 1) PG8_BAR;
        PG8_WAIT_V(2); PG8_BAR;
        PG8_STAGE(PG8_SB(1, 0), cB + kstep, voffB); PG8_STAGE(PG8_SA(1, 0), cA + kstep, voffA); PG8_STAGE(PG8_SB(1, 1), cB + hstep + kstep, voffB);
        PG8_WAIT_V(6); PG8_BAR;
    } else {
        PG8_STAGE(PG8_SB(0, 0), cB, voffB); PG8_STAGE(PG8_SA(0, 0), cA, voffA); PG8_STAGE(PG8_SB(0, 1), cB + hstep, voffB); PG8_STAGE(PG8_SA(0, 1), cA + hstep, voffA);
        if (wr == 1) PG8_BAR;
        PG8_WAIT_V(4); PG8_BAR;
        PG8_STAGE(PG8_SB(1, 0), cB + kstep, voffB); PG8_STAGE(PG8_SA(1, 0), cA + kstep, voffA); PG8_STAGE(PG8_SB(1, 1), cB + hstep + kstep, voffB);
        PG8_WAIT_V(6); PG8_BAR;
    }
    for (;;) {
        const bool has_next = S.next(ui + 1, nxt);
        const char* nA = has_next ? (const char*)g.A + (size_t)nxt.pm * tstep : cA; const char* nB = has_next ? (const char*)g.Bt + (size_t)nxt.pn * tstep : cB;
        for (int t = 0; t < nt; t += 2) {
            const bool last = (t == nt - 2);
            const char* a1 = cA + (size_t)(t + 1) * kstep;
            const char* a2 = last ? nA : cA + (size_t)(t + 2) * kstep; const char* b2 = last ? nB : cB + (size_t)(t + 2) * kstep;
            const char* a3 = a2 + kstep; const char* b3 = b2 + kstep;
            if (last && has_next) S.a_ready(nxt);
            if constexpr (SP2) {
            PG8_LDB(B0, 0, 0); PG8_LDB(B1, 0, 1); PG8_SCHED; PG8_LDA(At, 0, 0); PG8_STAGE(PG8_SA(1, 1), a1 + hstep, voffA);
            PG8_WAIT_V(8); PG8_WAIT_L(0); PG8_BAR; PG8_MMA(0, 0, At, B0); PG8_MMA(0, 1, At, B1); PG8_BAR; PG8_SCHED;
            PG8_LDA(At, 0, 1); PG8_STAGE(PG8_SB(0, 0), b2, voffB); PG8_STAGE(PG8_SB(0, 1), b2 + hstep, voffB); PG8_STAGE(PG8_SA(0, 0), a2, voffA);
            PG8_WAIT_V(8); PG8_WAIT_L(0); PG8_BAR; PG8_MMA(1, 0, At, B0); PG8_MMA(1, 1, At, B1); PG8_BAR; PG8_SCHED;
            PG8_LDB(B0, 1, 0); PG8_LDB(B1, 1, 1); PG8_SCHED; PG8_LDA(At, 1, 0); PG8_STAGE(PG8_SA(0, 1), a2 + hstep, voffA);
            PG8_WAIT_V(8); PG8_WAIT_L(0); PG8_BAR; PG8_MMA(0, 0, At, B0); PG8_MMA(0, 1, At, B1); PG8_BAR; PG8_SCHED;
            PG8_LDA(At, 1, 1); PG8_STAGE(PG8_SB(1, 0), b3, voffB); PG8_STAGE(PG8_SB(1, 1), b3 + hstep, voffB); PG8_STAGE(PG8_SA(1, 0), a3, voffA);
            PG8_WAIT_V(8); PG8_WAIT_L(0); PG8_BAR; PG8_MMA(1, 0, At, B0); PG8_MMA(1, 1, At, B1); PG8_BAR; PG8_SCHED;
            } else {
            PG8_LDB(B0, 0, 0); PG8_SCHED; PG8_LDA(At, 0, 0); PG8_STAGE(PG8_SA(1, 1), a1 + hstep, voffA);
            PG8_WAIT_L(8); PG8_BAR; PG8_WAIT_L(0); PG8_MMA(0, 0, At, B0); PG8_BAR; PG8_SCHED;
            PG8_LDB(B1, 0, 1); PG8_STAGE(PG8_SB(0, 0), b2, voffB);
            PG8_BAR; PG8_WAIT_L(0); PG8_MMA(0, 1, At, B1); PG8_BAR;
            PG8_LDA(At, 0, 1); PG8_STAGE(PG8_SA(0, 0), a2, voffA);
            PG8_BAR; PG8_WAIT_L(0); PG8_MMA(1, 0, At, B0); PG8_BAR; PG8_SCHED;
            PG8_STAGE(PG8_SB(0, 1), b2 + hstep, voffB);
            PG8_WAIT_V(6); PG8_BAR; PG8_MMA(1, 1, At, B1); PG8_BAR;
            PG8_LDB(B0, 1, 0); PG8_SCHED; PG8_LDA(At, 1, 0); PG8_STAGE(PG8_SA(0, 1), a2 + hstep, voffA);
            PG8_WAIT_L(8); PG8_BAR; PG8_WAIT_L(0); PG8_MMA(0, 0, At, B0); PG8_BAR; PG8_SCHED;
            PG8_LDB(B1, 1, 1); PG8_STAGE(PG8_SB(1, 0), b3, voffB);
            PG8_BAR; PG8_WAIT_L(0); PG8_MMA(0, 1, At, B1); PG8_BAR;
            PG8_LDA(At, 1, 1); PG8_STAGE(PG8_SA(1, 0), a3, voffA);
            PG8_BAR; PG8_WAIT_L(0); PG8_MMA(1, 0, At, B0); PG8_BAR; PG8_SCHED;
            PG8_STAGE(PG8_SB(1, 1), b3 + hstep, voffB);
            PG8_WAIT_V(6); PG8_BAR; PG8_MMA(1, 1, At, B1); PG8_BAR;
            }
        }
        if constexpr (ALIGN_EPI) { if (wr == 0) PG8_BAR; }
        if constexpr (!Epi::AFTER_DRAIN) { E(acc, cur, wr, wc, fr, fq); S.done(cur); }
        if (!has_next) break;
#pragma unroll
        for (int a = 0; a < 2; ++a)
#pragma unroll
            for (int b = 0; b < 2; ++b)
#pragma unroll
                for (int m = 0; m < 4; ++m)
#pragma unroll
                    for (int n = 0; n < 2; ++n) acc[a][b][m][n] = (f32x4){0.f, 0.f, 0.f, 0.f};
        cur = nxt; cA = nA; cB = nB; ++ui;
        if constexpr (ALIGN_EPI) { if (wr == 1) PG8_BAR; }
    }
    PG8_WAIT_V(0);
    if constexpr (!ALIGN_EPI) { if (wr == 0) PG8_BAR; }
    PG8_BAR;
    if constexpr (Epi::AFTER_DRAIN) { E.fused(acc, cur, wr, wc, fr, fq, lds, wid, lane); S.done(cur); }
#undef PG8_SA
#undef PG8_SB
#undef PG8_STAGE
#undef PG8_LDA
#undef PG8_LDB
#undef PG8_MMA
#undef PG8_WAIT_V
#undef PG8_WAIT_L
#undef PG8_BAR
#undef PG8_SCHED
}
}

namespace att {
#define ALAS __attribute__((address_space(3)))
typedef unsigned short bf16_t;
typedef short bf16x8 __attribute__((ext_vector_type(8)));
typedef short s16x4 __attribute__((ext_vector_type(4)));
typedef float f32x16 __attribute__((ext_vector_type(16)));
typedef float f32x4 __attribute__((ext_vector_type(4)));
typedef unsigned u32x4 __attribute__((ext_vector_type(4)));
constexpr int KVBLK = 64, QBLK = 32, SHM_K = 16384, SHM_V = 16384;
constexpr int GRP_BYTES = 2 * SHM_V + 2 * SHM_K + 512;
constexpr int SCR_OFF = 2 * GRP_BYTES;
constexpr int LDS_NEED = SCR_OFF + 8 * 256;
constexpr float SCALE = 0.08838834764831845f, THR = 8.f;
#define KSWZ(row, colB) ((row) * 256 + ((colB) ^ (((row) & 7) << 4)))
#define SBAR() __builtin_amdgcn_sched_barrier(0)
__device__ __forceinline__ int v_st(int k, int c) { const int kk = (k & ~0xC) | ((k & 4) << 1) | ((k & 8) >> 1); return ((kk >> 3) * 4 + (c >> 5)) * 512 + ((kk & 7) * 32 + (c & 31)) * 2; }
__device__ __forceinline__ int v_rd_base(int lane) { return ((lane & 3) << 3) | (((lane >> 2) & 3) << 6) | (((lane >> 4) & 1) << 5) | (((lane >> 5) & 1) << 8); }
__device__ __forceinline__ int crow(int r, int hi) { return (r & 3) + 8 * (r >> 2) + 4 * hi; }
__device__ __forceinline__ unsigned cvtpk(float lo, float hi) { unsigned r; asm volatile("v_cvt_pk_bf16_f32 %0, %1, %2" : "=v"(r) : "v"(lo), "v"(hi)); return r; }
__device__ __forceinline__ void mask_tile(f32x16& p0, f32x16& p1, int dq, unsigned W) {
    const float NEG = -__builtin_inff();
#pragma unroll
    for (int r = 0; r < 16; ++r) { const int c = (r & 3) + 8 * (r >> 2);
        if ((unsigned)(dq - c) >= W) p0[r] = NEG;
        if ((unsigned)(dq - c - 32) >= W) p1[r] = NEG; }
}
__device__ __forceinline__ void partialSM(f32x16& p0, f32x16& p1, float& m_reg, float& mn, float& alpha) {
    float pmax = p0[0];
#pragma unroll
    for (int r = 1; r < 16; ++r) pmax = fmaxf(pmax, p0[r]);
#pragma unroll
    for (int r = 0; r < 16; ++r) pmax = fmaxf(pmax, p1[r]);
    { auto rr = __builtin_amdgcn_permlane32_swap(__float_as_uint(pmax), __float_as_uint(pmax), false, false);
      pmax = fmaxf(__uint_as_float(rr[0]), __uint_as_float(rr[1])); }
    constexpr float C2 = 1.4426950408889634f * SCALE;
    if (__builtin_expect(__all((pmax - m_reg) * SCALE <= THR), 1)) { mn = m_reg; alpha = 1.f; }
    else { mn = fmaxf(m_reg, pmax); alpha = __builtin_amdgcn_exp2f((m_reg - mn) * C2); m_reg = mn; }
    const float mnL = -mn * C2;
#pragma unroll
    for (int r = 0; r < 16; ++r) p0[r] = fmaf(p0[r], C2, mnL);
#pragma unroll
    for (int r = 0; r < 16; ++r) p1[r] = fmaf(p1[r], C2, mnL);
#pragma unroll
    for (int r = 0; r < 16; ++r) p0[r] = __builtin_amdgcn_exp2f(p0[r]);
}
__device__ __forceinline__ void finishSM(f32x16& p0, f32x16& p1, float alpha, float& l_reg, bf16x8& pa0, bf16x8& pa1, bf16x8& pa2, bf16x8& pa3) {
#pragma unroll
    for (int r = 0; r < 16; ++r) p1[r] = __builtin_amdgcn_exp2f(p1[r]);
    float ps = 0;
#pragma unroll
    for (int r = 0; r < 16; ++r) ps += p0[r];
#pragma unroll
    for (int r = 0; r < 16; ++r) ps += p1[r];
    { auto rr = __builtin_amdgcn_permlane32_swap(__float_as_uint(ps), __float_as_uint(ps), false, false);
      ps = __uint_as_float(rr[0]) + __uint_as_float(rr[1]); }
    l_reg = l_reg * alpha + ps;
#define PK4(P, B_, OUT) do { unsigned a0 = cvtpk(P[B_+0], P[B_+1]), a1 = cvtpk(P[B_+2], P[B_+3]);                          \
        unsigned b0 = cvtpk(P[B_+4], P[B_+5]), b1 = cvtpk(P[B_+6], P[B_+7]);                                             \
        auto r0 = __builtin_amdgcn_permlane32_swap(a0, b0, false, false); auto r1 = __builtin_amdgcn_permlane32_swap(a1, b1, false, false); \
        u32x4 w = {r0[0], r1[0], r0[1], r1[1]}; OUT = __builtin_bit_cast(bf16x8, w); } while (0)
    PK4(p0, 0, pa0); PK4(p0, 8, pa1); PK4(p1, 0, pa2); PK4(p1, 8, pa3);
#undef PK4
}
__device__ __forceinline__ void qkt(f32x16& p0, f32x16& p1, const ALAS char* Kb, int r32, int hi, const bf16x8* qr) {
    p0 = f32x16{}; p1 = f32x16{};
    const ALAS char* kb[4];
#pragma unroll
    for (int dd = 0; dd < 4; ++dd) kb[dd] = Kb + KSWZ(r32, (dd * 16 + hi * 8) * 2);
#pragma unroll
    for (int d0 = 0; d0 < 8; ++d0) { const ALAS char* a = kb[d0 & 3] + (d0 >> 2) * 128;
        const bf16x8 b0 = *(const ALAS bf16x8*)a;
        const bf16x8 b1 = *(const ALAS bf16x8*)(a + 32 * 256);
        p0 = __builtin_amdgcn_mfma_f32_32x32x16_bf16(b0, qr[d0], p0, 0, 0, 0);
        p1 = __builtin_amdgcn_mfma_f32_32x32x16_bf16(b1, qr[d0], p1, 0, 0, 0); }
}
__device__ __forceinline__ void pv_tile(f32x16* o, int vb0, bf16x8 pa0, bf16x8 pa1, bf16x8 pa2, bf16x8 pa3) {
#define TRRD(dst, off) asm volatile("ds_read_b64_tr_b16 %0, %1 offset:%2" : "=&v"(dst) : "v"(vb0), "i"(off) : "memory")
#define PV_D0(d0) do { s16x4 l0, l1, l2, l3, h0, h1, h2, h3; constexpr int b_ = (d0) * 512;   \
        TRRD(l0, b_); TRRD(h0, b_ + 2048); TRRD(l1, b_ + 4096); TRRD(h1, b_ + 6144); TRRD(l2, b_ + 8192); TRRD(h2, b_ + 10240); TRRD(l3, b_ + 12288); TRRD(h3, b_ + 14336); \
        asm volatile("s_waitcnt lgkmcnt(0)" ::: "memory"); SBAR();   \
        o[d0] = __builtin_amdgcn_mfma_f32_32x32x16_bf16(pa0, (bf16x8){l0[0], l0[1], l0[2], l0[3], h0[0], h0[1], h0[2], h0[3]}, o[d0], 0, 0, 0);   \
        o[d0] = __builtin_amdgcn_mfma_f32_32x32x16_bf16(pa1, (bf16x8){l1[0], l1[1], l1[2], l1[3], h1[0], h1[1], h1[2], h1[3]}, o[d0], 0, 0, 0);   \
        o[d0] = __builtin_amdgcn_mfma_f32_32x32x16_bf16(pa2, (bf16x8){l2[0], l2[1], l2[2], l2[3], h2[0], h2[1], h2[2], h2[3]}, o[d0], 0, 0, 0);   \
        o[d0] = __builtin_amdgcn_mfma_f32_32x32x16_bf16(pa3, (bf16x8){l3[0], l3[1], l3[2], l3[3], h3[0], h3[1], h3[2], h3[3]}, o[d0], 0, 0, 0); } while (0)
    PV_D0(0); PV_D0(1); PV_D0(2); PV_D0(3);
#undef PV_D0
#undef TRRD
}
struct Unit { const bf16_t* Q; const bf16_t* K; const bf16_t* V; bf16_t* O; long ldq, ldk; int P0, W, j_lo, NT; float* lse; long lse_ld; const float* bias; };
template <bool SHARED, bool BIAS>
__device__ __forceinline__ void attn_unit(const Unit& U, ALAS char* lds) {
    const int tid = threadIdx.x, wid = __builtin_amdgcn_readfirstlane(tid >> 6), lane = tid & 63, r32 = lane & 31, hi = lane >> 5;
    const int grp = SHARED ? 0 : (wid >> 2), gw = SHARED ? wid : (wid & 3), gtid = SHARED ? tid : (tid & 255);
    ALAS char* V_lds = lds + grp * GRP_BYTES; ALAS char* K_lds = V_lds + 2 * SHM_V; ALAS char* B_lds = K_lds + 2 * SHM_K;
    ALAS float* ws = (ALAS float*)(lds + SCR_OFF) + wid * 64; ALAS float* li_l = ws; ALAS float* al_l = ws + 32;
    constexpr int NST = SHARED ? 2 : 4, RSTEP = SHARED ? 32 : 16;
    const int sr = gtid >> 4, sc = (gtid & 15) * 8;
    bf16x8 qr[8];
    { const bf16_t* qp = U.Q + (size_t)(gw * QBLK + r32) * U.ldq + hi * 8;
#pragma unroll
      for (int d0 = 0; d0 < 8; ++d0) qr[d0] = *(const bf16x8*)(qp + d0 * 16); }
    bf16x8 stk[NST], stv[NST]; f32x4 stb = {0.f, 0.f, 0.f, 0.f};
#define LOADT(t) do { const size_t k0_ = (size_t)(U.j_lo + (t)) * KVBLK; _Pragma("unroll") for (int i = 0; i < NST; ++i) { \
        stk[i] = *(const bf16x8*)(U.K + (k0_ + sr + i * RSTEP) * U.ldk + sc); stv[i] = *(const bf16x8*)(U.V + (k0_ + sr + i * RSTEP) * U.ldk + sc); } \
        if (BIAS) { if (gtid < 16) stb = *(const f32x4*)(U.bias + k0_ + gtid * 4); } } while (0)
#define WRITET(bf) do { _Pragma("unroll") for (int i = 0; i < NST; ++i) { const int row_ = sr + i * RSTEP; \
        *(ALAS bf16x8*)(K_lds + (bf) * SHM_K + KSWZ(row_, sc * 2)) = stk[i]; *(ALAS bf16x8*)(V_lds + (bf) * SHM_V + v_st(row_, sc)) = stv[i]; } \
        if (BIAS) { if (gtid < 16) *(ALAS f32x4*)(B_lds + (bf) * 256 + gtid * 16) = stb; } } while (0)
    LOADT(0); WRITET(0);
    if (U.NT > 1) LOADT(1);
    const int qlo = U.P0 + gw * QBLK, qm = qlo + r32 - 4 * hi;
    float m_reg = -1e30f, l_reg = 0.f; f32x16 o[4] = {};
    const int vbase = (int)(uintptr_t)V_lds + v_rd_base(lane);
    for (int t = 0; t < U.NT; ++t) {
        asm volatile("s_waitcnt lgkmcnt(0)\n\ts_barrier" ::: "memory");
        const int bf = t & 1;
        if (t + 1 < U.NT) WRITET(bf ^ 1);
        if (t + 2 < U.NT) LOADT(t + 2);
        const int kb = (U.j_lo + t) * KVBLK;
        const bool act = (kb <= qlo + QBLK - 1) && (kb + KVBLK - 1 >= qlo - U.W + 1);
        if (act) {
            f32x16 p0, p1; float mn, alpha; bf16x8 pa0, pa1, pa2, pa3;
            qkt(p0, p1, K_lds + bf * SHM_K, r32, hi, qr);
            if (BIAS) { const ALAS char* bp = B_lds + bf * 256 + hi * 16;
#pragma unroll
                for (int g = 0; g < 4; ++g) { const f32x4 b0 = *(const ALAS f32x4*)(bp + g * 32), b1 = *(const ALAS f32x4*)(bp + 128 + g * 32);
#pragma unroll
                    for (int j = 0; j < 4; ++j) { p0[4 * g + j] += b0[j]; p1[4 * g + j] += b1[j]; } } }
            if (kb + KVBLK - 1 > qlo || kb <= qlo + QBLK - 1 - U.W) mask_tile(p0, p1, qm - kb, (unsigned)U.W);
            partialSM(p0, p1, m_reg, mn, alpha);
            if (__any(alpha < 1.f)) { if (hi == 0) al_l[r32] = alpha; asm volatile("s_waitcnt lgkmcnt(0)" ::: "memory");
#pragma unroll
                for (int d_ = 0; d_ < 4; ++d_)
#pragma unroll
                    for (int r = 0; r < 16; ++r) o[d_][r] *= al_l[crow(r, hi)]; }
            finishSM(p0, p1, alpha, l_reg, pa0, pa1, pa2, pa3); SBAR();
            pv_tile(o, vbase + bf * SHM_V, pa0, pa1, pa2, pa3);
        }
    }
    if (hi == 0) { li_l[r32] = l_reg; if (U.lse) U.lse[(size_t)(gw * QBLK + r32) * U.lse_ld] = m_reg * SCALE + __logf(l_reg); }
    asm volatile("s_waitcnt lgkmcnt(0)" ::: "memory");
    float rli[16];
#pragma unroll
    for (int r = 0; r < 16; ++r) rli[r] = __builtin_amdgcn_rcpf(li_l[crow(r, hi)]);
    bf16_t* Ow = U.O + (size_t)(gw * QBLK) * U.ldq;
#pragma unroll
    for (int r = 0; r < 16; ++r) { const int orow = crow(r, hi);
#pragma unroll
        for (int d0 = 0; d0 < 4; ++d0) { const float v = o[d0][r] * rli[r]; const float vn = __shfl_xor(v, 1);
            if ((r32 & 1) == 0) *(unsigned*)(Ow + (size_t)orow * U.ldq + d0 * 32 + r32) = cvtpk(v, vn); } }
    asm volatile("s_waitcnt lgkmcnt(0)\n\ts_barrier" ::: "memory");
#undef LOADT
#undef WRITET
}
#undef SBAR
}

constexpr int BATCH = 16, SEQ = 2048, DM = 2048, M = BATCH * SEQ, HD = 128;
constexpr int NQKV = 9216, WA = 1024, DFF = 5632, NFFN = 2 * DFF, NKV = 4096, NKVF = 4352;
constexpr int MODS_LD = 28672;
constexpr float EPS = 1e-6f;
constexpr int NWAVES = 8, NPHASE = 18;
#ifndef MK_N_LAUNCHES
#define MK_N_LAUNCHES 18
#endif
constexpr size_t MiB = 1u << 20;
constexpr size_t WS_ROPE = 1 * MiB, WS_MODS = 2 * MiB, WS_LOGF = 4 * MiB, WS_FB = 6 * MiB, WS_LSE = 8 * MiB;
constexpr size_t WS_WQKV = 16 * MiB, WS_WOA = 52 * MiB, WS_WKV = 56 * MiB, WS_WQB = 73 * MiB, WS_WOB = 81 * MiB, WS_WFI = 89 * MiB, WS_WFO = 177 * MiB;
constexpr size_t WS_H = 224 * MiB, WS_BIG = 352 * MiB, WS_OCOMB = 928 * MiB, WS_END = 992 * MiB;
constexpr size_t WS_H2 = 352 * MiB, WS_QB = 480 * MiB, WS_KV = 608 * MiB;
constexpr int LDS_BYTES = 147456;

#define LAS __attribute__((address_space(3)))
typedef unsigned short bf16;
typedef unsigned v4u __attribute__((ext_vector_type(4)));
typedef unsigned v2u __attribute__((ext_vector_type(2)));
typedef float f32x4 __attribute__((ext_vector_type(4)));
typedef float f32x2 __attribute__((ext_vector_type(2)));
__device__ __forceinline__ unsigned pk2(float lo, float hi) { unsigned r; asm volatile("v_cvt_pk_bf16_f32 %0, %1, %2" : "=v"(r) : "v"(lo), "v"(hi)); return r; }
__device__ __forceinline__ float bf_lo(unsigned w) { return __uint_as_float(w << 16); }
__device__ __forceinline__ float bf_hi(unsigned w) { return __uint_as_float(w & 0xffff0000u); }
__device__ __forceinline__ float wave_sum(float v) {
#pragma unroll
    for (int o = 1; o < 64; o <<= 1) v += __shfl_xor(v, o);
    return v;
}
struct Args { const float* in[21]; float* out; unsigned char* ws; int ph_lo, ph_hi; };
enum { I_X = 0, I_C, I_WADA, I_BADA, I_GNA, I_GNF, I_WQKVA, I_GQKA, I_WOA, I_WADAKV, I_BADAKV, I_GNKV, I_WKV, I_GKB, I_WF, I_BF, I_WQB, I_GQB, I_WOB, I_WFI, I_WFO };

__device__ __forceinline__ void transpose_item(const float* W, int K, int N, bf16* WT, int k0, int n0, int nd0, LAS float* scr, int lane) {
#pragma unroll 8
    for (int i = 0; i < 32; ++i) { const int kk = 2 * i + (lane >> 5); scr[kk * 33 + (lane & 31)] = W[(size_t)(k0 + kk) * N + n0 + (lane & 31)]; }
    asm volatile("s_waitcnt lgkmcnt(0)" ::: "memory");
    const int c = lane & 7;
#pragma unroll
    for (int j = 0; j < 4; ++j) { const int n = (lane >> 3) + 8 * j; const LAS float* s = scr + (8 * c) * 33 + n;
        v4u o; o.x = pk2(s[0 * 33], s[1 * 33]); o.y = pk2(s[2 * 33], s[3 * 33]); o.z = pk2(s[4 * 33], s[5 * 33]); o.w = pk2(s[6 * 33], s[7 * 33]);
        *(v4u*)(WT + (size_t)(nd0 + n) * K + k0 + 8 * c) = o; }
    asm volatile("s_waitcnt lgkmcnt(0)" ::: "memory");
}
__device__ __forceinline__ void transpose_matrix_items(const float* W, int K, int N, bf16* WT, int kind, int item, LAS float* scr, int lane) {
    const int nblk = N / 32, kb = item / nblk, nb = item % nblk, n0 = 32 * nb; int nd0 = n0;
    if (kind == 1) { const int half = n0 >= DFF, nn = n0 - half * DFF; nd0 = 256 * (nn >> 7) + 128 * half + (nn & 127); }
    transpose_item(W, K, N, WT, 64 * kb, n0, nd0, scr, lane);
}
__device__ __forceinline__ void sincos_d(double a, double& s, double& c) {
    const double n = rint(a * 0.6366197723675814); const int q = (int)n & 3;
    double r = fma(-n, 1.5707963267948966, a); r = fma(-n, 6.123233995736766e-17, r);
    const double r2 = r * r;
    double sp = -7.647163731819816e-13; sp = fma(sp, r2, 1.6059043836821613e-10); sp = fma(sp, r2, -2.505210838544172e-08); sp = fma(sp, r2, 2.7557319223985893e-06);
    sp = fma(sp, r2, -1.984126984126984e-04); sp = fma(sp, r2, 8.333333333333333e-03); sp = fma(sp, r2, -1.6666666666666666e-01); sp = fma(sp * r2, r, r);
    double cp = 4.779477332387385e-14; cp = fma(cp, r2, -1.1470745597729725e-11); cp = fma(cp, r2, 2.08767569878681e-09); cp = fma(cp, r2, -2.755731922398589e-07);
    cp = fma(cp, r2, 2.48015873015873e-05); cp = fma(cp, r2, -1.388888888888889e-03); cp = fma(cp, r2, 4.1666666666666664e-02); cp = fma(cp, r2, -0.5); cp = fma(cp, r2, 1.0);
    s = (q == 0) ? sp : (q == 1) ? cp : (q == 2) ? -sp : -cp;
    c = (q == 0) ? cp : (q == 1) ? -sp : (q == 2) ? -cp : sp;
}
__device__ __forceinline__ float rope_inv(int i) {
    switch (i) { case 0: return 1.0f; case 1: return 0.44036659598350525f; case 2: return 0.1939227432012558f; case 3: return 0.08539710193872452f;
        case 4: return 0.03760603070259094f; case 5: return 0.01656043902039528f; case 6: return 0.007292664609849453f; case 7: return 0.0032114458736032248f;
        case 8: return 0.0014142135623842478f; case 9: return 0.000622772378847003f; case 10: return 0.00027424818836152554f; case 11: return 0.00012076973507646471f;
        case 12: return 5.318296098266728e-05f; case 13: return 2.34199997066753e-05f; case 14: return 1.0313386155758053e-05f; default: return 4.541670477919979e-06f; }
}
__device__ __forceinline__ void phase_prologue(const Args& a, LAS unsigned char* lds) {
    const int tid = threadIdx.x, lane = tid & 63, wave = __builtin_amdgcn_readfirstlane(tid >> 6), G = gridDim.x;
    unsigned char* ws = a.ws;
    for (int tk = blockIdx.x; tk < MODS_LD / 128; tk += G) {
        LAS float* ct = (LAS float*)lds;
        for (int idx = tid; idx < BATCH * DM; idx += NWAVES * 64) { const int b = idx >> 11, k = idx & 2047; const float v = a.in[I_C][idx]; ct[k * 16 + b] = v / (1.f + __expf(-v)); }
        __syncthreads();
        const int col0 = tk * 128; const float* W; int pitch, wc0; const float* bias;
        if (col0 < 2 * 12288) { const int l = col0 / 12288; wc0 = col0 - l * 12288; W = a.in[I_WADA] + (size_t)l * DM * 12288; pitch = 12288; bias = a.in[I_BADA] + col0; }
        else { wc0 = col0 - 2 * 12288; W = a.in[I_WADAKV]; pitch = 4096; bias = a.in[I_BADAKV] + wc0; }
        float acc[16][2];
#pragma unroll
        for (int b = 0; b < 16; ++b) { acc[b][0] = 0.f; acc[b][1] = 0.f; }
        const float* wp = W + (size_t)(wave * 256) * pitch + wc0 + 2 * lane;
#pragma unroll 8
        for (int k = 0; k < 256; ++k) { const f32x2 wv = *(const f32x2*)(wp + (size_t)k * pitch); const LAS f32x4* cp = (const LAS f32x4*)(ct + (wave * 256 + k) * 16);
#pragma unroll
            for (int q = 0; q < 4; ++q) { const f32x4 cv = cp[q];
#pragma unroll
                for (int j = 0; j < 4; ++j) { acc[4 * q + j][0] = fmaf(cv[j], wv.x, acc[4 * q + j][0]); acc[4 * q + j][1] = fmaf(cv[j], wv.y, acc[4 * q + j][1]); } } }
        __syncthreads();
        LAS float* red = (LAS float*)lds;
#pragma unroll
        for (int b = 0; b < 16; ++b) { red[(wave * 16 + b) * 128 + 2 * lane] = acc[b][0]; red[(wave * 16 + b) * 128 + 2 * lane + 1] = acc[b][1]; }
        __syncthreads();
        float* mods = (float*)(ws + WS_MODS);
        for (int idx = tid; idx < 16 * 128; idx += NWAVES * 64) { const int b = idx >> 7, cc = idx & 127; float s = bias[cc];
#pragma unroll
            for (int w = 0; w < 8; ++w) s += red[(w * 16 + b) * 128 + cc];
            mods[(size_t)b * MODS_LD + col0 + cc] = s; }
        __syncthreads();
    }
    { float* rt = (float*)(ws + WS_ROPE);
      for (int idx = blockIdx.x * (NWAVES * 64) + tid; idx < SEQ * 16; idx += G * NWAVES * 64) { const int t = idx >> 4, i = idx & 15;
          const float ang = (float)t * rope_inv(i); double s, c; sincos_d((double)ang, s, c); rt[idx] = (float)c; rt[SEQ * 16 + idx] = (float)s; } }
    { bf16* wkv = (bf16*)(ws + WS_WKV) + (size_t)NKV * DM;
      for (int idx = blockIdx.x * (NWAVES * 64) + tid; idx < 256 * DM; idx += G * NWAVES * 64) { const int n = idx >> 11, k = idx & 2047;
          wkv[idx] = n < 16 ? (bf16)(pk2(a.in[I_WF][k * 16 + n], 0.f) & 0xffffu) : (bf16)0; } }
    LAS float* scr = (LAS float*)(lds + wave * 16384);
    const int gw = blockIdx.x * NWAVES + wave, NGW = G * NWAVES;
    constexpr int I0 = (DM / 64) * (NQKV / 32), I1 = (WA / 64) * (DM / 32), I2 = (DM / 64) * (NKV / 32), I3 = (DM / 64) * (DM / 32), I5 = (DM / 64) * (NFFN / 32), I7 = (DFF / 64) * (DM / 32);
    constexpr int NIT = I0 + I1 + I2 + 2 * I3 + 2 * I5 + 2 * I7;
    for (int it = gw; it < NIT; it += NGW) {
        int r = it;
        if (r < I0) { transpose_matrix_items(a.in[I_WQKVA], DM, NQKV, (bf16*)(ws + WS_WQKV), 0, r, scr, lane); continue; } r -= I0;
        if (r < I1) { transpose_matrix_items(a.in[I_WOA], WA, DM, (bf16*)(ws + WS_WOA), 0, r, scr, lane); continue; } r -= I1;
        if (r < I2) { transpose_matrix_items(a.in[I_WKV], DM, NKV, (bf16*)(ws + WS_WKV), 0, r, scr, lane); continue; } r -= I2;
        if (r < I3) { transpose_matrix_items(a.in[I_WQB], DM, DM, (bf16*)(ws + WS_WQB), 0, r, scr, lane); continue; } r -= I3;
        if (r < I3) { transpose_matrix_items(a.in[I_WOB], DM, DM, (bf16*)(ws + WS_WOB), 0, r, scr, lane); continue; } r -= I3;
        if (r < 2 * I5) { const int l = r / I5; transpose_matrix_items(a.in[I_WFI] + (size_t)l * DM * NFFN, DM, NFFN, (bf16*)(ws + WS_WFI) + (size_t)l * NFFN * DM, 1, r - l * I5, scr, lane); continue; } r -= 2 * I5;
        { const int l = r / I7; transpose_matrix_items(a.in[I_WFO] + (size_t)l * DFF * DM, DFF, DM, (bf16*)(ws + WS_WFO) + (size_t)l * DM * DFF, 0, r - l * I7, scr, lane); }
    }
}
template <bool DUAL>
__device__ __forceinline__ void phase_norm(const float* x, const float* g1, const float* sh1, const float* sc1, bf16* o1,
                                           const float* g2, const float* sh2, const float* sc2, bf16* o2) {
    const int lane = threadIdx.x & 63, wave = threadIdx.x >> 6; const int gw = blockIdx.x * NWAVES + wave, NGW = gridDim.x * NWAVES;
    for (int row = gw; row < M; row += NGW) {
        const int b = row >> 11; const f32x4* xr = (const f32x4*)(x + (size_t)row * DM) + lane;
        f32x4 v[8]; float s = 0.f;
#pragma unroll
        for (int j = 0; j < 8; ++j) { v[j] = xr[64 * j]; s += (v[j].x * v[j].x + v[j].y * v[j].y) + (v[j].z * v[j].z + v[j].w * v[j].w); }
        const float rstd = 1.0f / sqrtf(wave_sum(s) * (1.f / DM) + EPS);
#pragma unroll
        for (int j = 0; j < 8; ++j) { const int col = 4 * lane + 256 * j;
            { const f32x4 gv = *(const f32x4*)(g1 + col), sh = *(const f32x4*)(sh1 + (size_t)b * MODS_LD + col), sc = *(const f32x4*)(sc1 + (size_t)b * MODS_LD + col);
              const f32x4 h = (v[j] * rstd * gv) * (sc + 1.f) + sh; v2u w; w.x = pk2(h.x, h.y); w.y = pk2(h.z, h.w); *(v2u*)(o1 + (size_t)row * DM + col) = w; }
            if (DUAL) { const f32x4 gv = *(const f32x4*)(g2 + col), sh = *(const f32x4*)(sh2 + (size_t)b * MODS_LD + col), sc = *(const f32x4*)(sc2 + (size_t)b * MODS_LD + col);
              const f32x4 h = (v[j] * rstd * gv) * (sc + 1.f) + sh; v2u w; w.x = pk2(h.x, h.y); w.y = pk2(h.z, h.w); *(v2u*)(o2 + (size_t)row * DM + col) = w; } }
    }
}
template <bool ROPE>
__device__ __forceinline__ void phase_qknorm(bf16* buf, size_t pitch, int nchunk, const float* gains, int gshift, const float* rope) {
    const int lane = threadIdx.x & 63, wave = threadIdx.x >> 6; const int gw = blockIdx.x * NWAVES + wave, NGW = gridDim.x * NWAVES;
    const int nq = nchunk >> 2, j = lane & 15; const long total = (long)M * nq;
    for (long it0 = gw; it0 < total; it0 += 4L * NGW) {
        v4u raw[4]; bf16* pp[4]; int ch[4], tok[4]; bool ok[4];
#pragma unroll
        for (int u = 0; u < 4; ++u) { const long it = it0 + (long)u * NGW; ok[u] = it < total; const long itc = ok[u] ? it : it0; tok[u] = (int)(itc / nq); ch[u] = (int)(itc % nq) * 4 + (lane >> 4);
            pp[u] = buf + (size_t)tok[u] * pitch + ch[u] * 128 + j * 8; raw[u] = *(const v4u*)pp[u]; }
#pragma unroll
        for (int u = 0; u < 4; ++u) {
            float x[8]; x[0] = bf_lo(raw[u].x); x[1] = bf_hi(raw[u].x); x[2] = bf_lo(raw[u].y); x[3] = bf_hi(raw[u].y); x[4] = bf_lo(raw[u].z); x[5] = bf_hi(raw[u].z); x[6] = bf_lo(raw[u].w); x[7] = bf_hi(raw[u].w);
            float ss = 0.f;
#pragma unroll
            for (int i = 0; i < 8; ++i) ss += x[i] * x[i];
            ss += __shfl_xor(ss, 1); ss += __shfl_xor(ss, 2); ss += __shfl_xor(ss, 4); ss += __shfl_xor(ss, 8);
            const float rstd = 1.0f / sqrtf(ss * (1.f / HD) + EPS);
            const float* gp = gains + (size_t)(ch[u] >> gshift) * HD + j * 8; const f32x4 g0 = *(const f32x4*)gp, g1 = *(const f32x4*)(gp + 4);
            float y[8];
#pragma unroll
            for (int i = 0; i < 4; ++i) { y[i] = x[i] * rstd * g0[i]; y[4 + i] = x[4 + i] * rstd * g1[i]; }
            if (ROPE) { const int pos = tok[u] & (SEQ - 1); const float* cp = rope + pos * 16 + (j & 1) * 8; const float* sp = cp + SEQ * 16;
#pragma unroll
                for (int i = 0; i < 8; ++i) { const float pv = __shfl_xor(y[i], 2); const float c = cp[i], s = sp[i];
                    const float r = (j < 2) ? (y[i] * c - pv * s) : (y[i] * c + pv * s); y[i] = (j < 4) ? r : y[i]; } }
            v4u w; w.x = pk2(y[0], y[1]); w.y = pk2(y[2], y[3]); w.z = pk2(y[4], y[5]); w.w = pk2(y[6], y[7]);
            if (ok[u]) *(v4u*)pp[u] = w;
        }
    }
}
__device__ __forceinline__ void phase_combine(const bf16* qkv, const float* lse, bf16* oc) {
    const int lane = threadIdx.x & 63, wave = threadIdx.x >> 6; const int gw = blockIdx.x * NWAVES + wave, NGW = gridDim.x * NWAVES;
    const int j = lane & 15; const long total = (long)M * 2;
    for (long it = gw; it < total; it += NGW) {
        const int tok = (int)(it >> 1), h = (int)(it & 1) * 4 + (lane >> 4);
        v4u raw[3]; float l[3];
#pragma unroll
        for (int g = 0; g < 3; ++g) { raw[g] = *(const v4u*)(qkv + (size_t)tok * NQKV + g * WA + h * HD + j * 8); l[g] = lse[((size_t)g * M + tok) * 8 + h]; }
        const float mx = fmaxf(l[0], fmaxf(l[1], l[2])); float e[3]; e[0] = __expf(l[0] - mx); e[1] = __expf(l[1] - mx); e[2] = __expf(l[2] - mx);
        const float inv = 1.f / (e[0] + e[1] + e[2]); float y[8];
#pragma unroll
        for (int i = 0; i < 8; ++i) y[i] = 0.f;
#pragma unroll
        for (int g = 0; g < 3; ++g) { const float al = e[g] * inv;
            y[0] += al * bf_lo(raw[g].x); y[1] += al * bf_hi(raw[g].x); y[2] += al * bf_lo(raw[g].y); y[3] += al * bf_hi(raw[g].y);
            y[4] += al * bf_lo(raw[g].z); y[5] += al * bf_hi(raw[g].z); y[6] += al * bf_lo(raw[g].w); y[7] += al * bf_hi(raw[g].w); }
        v4u w; w.x = pk2(y[0], y[1]); w.y = pk2(y[2], y[3]); w.z = pk2(y[4], y[5]); w.w = pk2(y[6], y[7]);
        *(v4u*)(oc + (size_t)tok * WA + h * HD + j * 8) = w;
    }
}
__device__ __forceinline__ void phase_scan(const float* logf, float* fb) {
    const int lane = threadIdx.x & 63, wave = threadIdx.x >> 6;
    if (wave != 0) return;
    for (int bh = blockIdx.x; bh < BATCH * 16; bh += gridDim.x) {
        const int b = bh >> 4, h = bh & 15; const float* p = logf + ((size_t)b * SEQ + lane * 32) * 16 + h;
        double tot = 0.0;
        for (int i = 0; i < 32; ++i) tot += (double)p[i * 16];
        double incl = tot;
#pragma unroll
        for (int o = 1; o < 64; o <<= 1) { const double t = __shfl_up(incl, o); if (lane >= o) incl += t; }
        double run = incl - tot;
        for (int i = 0; i < 32; ++i) { run += (double)p[i * 16]; fb[(size_t)bh * SEQ + lane * 32 + i] = (float)(-run * 11.313708498984761); }
    }
}
__device__ __forceinline__ void phase_attn_a(bf16* qkv, float* lse, LAS unsigned char* lds) {
    const int wid = __builtin_amdgcn_readfirstlane(threadIdx.x >> 6), half = wid >> 2;
    constexpr int NU = BATCH * 3 * 4 * 16;
    for (int u = blockIdx.x; u < NU; u += gridDim.x) {
        const int g = u >> 10, rem = u & 1023, bhp = rem >> 4, idx = rem & 15, b = bhp >> 2, h = (bhp & 3) * 2 + half;
        int dil, res, qb;
        if (g == 0) { dil = 1; res = 0; qb = idx; } else if (g == 1) { dil = 4; res = idx & 3; qb = idx >> 2; } else { dil = 16; res = idx; qb = 0; }
        const size_t tok0 = (size_t)b * SEQ + res;
        att::Unit U;
        const bf16* base = qkv + tok0 * NQKV + h * HD;
        U.ldq = (long)NQKV * dil; U.ldk = U.ldq;
        U.Q = base + (size_t)g * WA + (size_t)(qb * 128) * U.ldq; U.O = (bf16*)U.Q;
        U.K = base + (size_t)(3 + g) * WA; U.V = base + (size_t)(6 + g) * WA;
        U.P0 = qb * 128; U.W = 129; U.j_lo = qb ? 2 * qb - 2 : 0; U.NT = qb ? 4 : 2;
        U.lse = lse + ((size_t)g * M + tok0 + (size_t)(qb * 128) * dil) * 8 + h; U.lse_ld = 8L * dil; U.bias = nullptr;
        att::attn_unit<false, false>(U, (ALAS char*)lds);
    }
}
__device__ __forceinline__ void phase_attn_b(bf16* qb_, const bf16* kv, const float* fb, LAS unsigned char* lds) {
    const int G = gridDim.x, bx = blockIdx.x; const int vcu = (G % 8 == 0) ? (bx % 8) * (G / 8) + bx / 8 : bx;
    constexpr int NU = BATCH * 16 * 8;
    for (int u = (G == 256 ? 0 : bx); u < (G == 256 ? 8 : NU); u += (G == 256 ? 1 : G)) {
        int bh, qblk;
        if (G == 256) { bh = (vcu >> 3) * 8 + u; qblk = ((vcu & 7) + u) & 7; } else { bh = u >> 3; qblk = u & 7; }
        const int b = bh >> 4, h = bh & 15;
        att::Unit U;
        U.ldq = DM; U.ldk = NKV;
        U.Q = qb_ + ((size_t)b * SEQ + qblk * 256) * DM + h * HD; U.O = (bf16*)U.Q;
        U.K = kv + (size_t)b * SEQ * NKV + h * HD; U.V = U.K + DM;
        U.P0 = qblk * 256; U.W = 1 << 30; U.j_lo = 0; U.NT = 4 * (qblk + 1);
        U.lse = nullptr; U.lse_ld = 0; U.bias = fb + (size_t)bh * SEQ;
        att::attn_unit<true, true>(U, (ALAS char*)lds);
    }
}

__global__ void __launch_bounds__(NWAVES * 64) yoco_fwd(Args a) {
    extern __shared__ __attribute__((aligned(16))) unsigned char lds_raw[];
    LAS unsigned char* lds = (LAS unsigned char*)lds_raw;
    cg::grid_group grid = cg::this_grid();
    unsigned char* ws = a.ws; const int G = gridDim.x, bx = blockIdx.x;
    const int lo = a.ph_lo, hi = a.ph_hi;
    float* mods = (float*)(ws + WS_MODS); float* xo = a.out;
    bf16* H = (bf16*)(ws + WS_H); bf16* H2 = (bf16*)(ws + WS_H2); bf16* QKV = (bf16*)(ws + WS_BIG); bf16* ACT = (bf16*)(ws + WS_BIG);
    bf16* OC = (bf16*)(ws + WS_OCOMB); bf16* QB = (bf16*)(ws + WS_QB); bf16* KV = (bf16*)(ws + WS_KV);
    float* LSE = (float*)(ws + WS_LSE); float* LOGF = (float*)(ws + WS_LOGF); float* FB = (float*)(ws + WS_FB); const float* ROPE = (const float*)(ws + WS_ROPE);
#define IN(k) (lo <= (k) && (k) < hi)
#define SEAM(k) do { if (IN(k) && IN((k) + 1)) grid.sync(); } while (0)
#define GEMM(EPI, Aptr, Bptr, N_, K_, E) do { pg8::Gemm g_{(const pg8::bf16_t*)(Aptr), (const pg8::bf16_t*)(Bptr), M, (N_), (K_)}; pg8::StaticOrder S_; S_.init(M, (N_), G, bx); \
        pg8::gemm_phase<EPI, pg8::StaticOrder, true, true>(lds, g_, S_, E); } while (0)
    if (IN(0)) { phase_prologue(a, lds); } SEAM(0);
    if (IN(1)) { phase_norm<false>(a.in[I_X], a.in[I_GNA], mods + 0, mods + 2048, H, nullptr, nullptr, nullptr, nullptr); } SEAM(1);
    if (IN(2)) { pg8::EpiStore E{QKV, NQKV, 1 << 30, nullptr, nullptr}; GEMM(pg8::EpiStore, H, ws + WS_WQKV, NQKV, DM, E); } SEAM(2);
    if (IN(3)) { phase_qknorm<true>(QKV, NQKV, 48, a.in[I_GQKA], 3, ROPE); } SEAM(3);
    if (IN(4)) { phase_attn_a(QKV, LSE, lds); } SEAM(4);
    if (IN(5)) { phase_combine(QKV, LSE, OC); } SEAM(5);
    if (IN(6)) { pg8::EpiResid E{a.in[I_X], xo, DM, mods + 4096, MODS_LD}; GEMM(pg8::EpiResid, OC, ws + WS_WOA, DM, WA, E); } SEAM(6);
    if (IN(7)) { phase_norm<false>(xo, a.in[I_GNF], mods + 6144, mods + 8192, H, nullptr, nullptr, nullptr, nullptr); } SEAM(7);
    if (IN(8)) { pg8::EpiSwiglu E{ACT, DFF}; GEMM(pg8::EpiSwiglu, H, ws + WS_WFI, NFFN, DM, E); } SEAM(8);
    if (IN(9)) { pg8::EpiResid E{xo, xo, DM, mods + 10240, MODS_LD}; GEMM(pg8::EpiResid, ACT, ws + WS_WFO, DM, DFF, E); } SEAM(9);
    if (IN(10)) { phase_norm<true>(xo, a.in[I_GNKV], mods + 24576, mods + 24576 + 2048, H, a.in[I_GNA] + DM, mods + 12288, mods + 12288 + 2048, H2); } SEAM(10);
    if (IN(11)) { { pg8::EpiStore E{KV, NKV, 16, LOGF, a.in[I_BF]}; GEMM(pg8::EpiStore, H, ws + WS_WKV, NKVF, DM, E); }
                  { pg8::EpiStore E{QB, DM, 1 << 30, nullptr, nullptr}; GEMM(pg8::EpiStore, H2, ws + WS_WQB, DM, DM, E); } } SEAM(11);
    if (IN(12)) { phase_qknorm<false>(KV, NKV, 16, a.in[I_GKB], 31, nullptr); phase_qknorm<false>(QB, DM, 16, a.in[I_GQB], 31, nullptr); phase_scan(LOGF, FB); } SEAM(12);
    if (IN(13)) { phase_attn_b(QB, KV, FB, lds); } SEAM(13);
    if (IN(14)) { pg8::EpiResid E{xo, xo, DM, mods + 12288 + 4096, MODS_LD}; GEMM(pg8::EpiResid, QB, ws + WS_WOB, DM, DM, E); } SEAM(14);
    if (IN(15)) { phase_norm<false>(xo, a.in[I_GNF] + DM, mods + 12288 + 6144, mods + 12288 + 8192, H, nullptr, nullptr, nullptr, nullptr); } SEAM(15);
    if (IN(16)) { pg8::EpiSwiglu E{ACT, DFF}; GEMM(pg8::EpiSwiglu, H, (bf16*)(ws + WS_WFI) + (size_t)NFFN * DM, NFFN, DM, E); } SEAM(16);
    if (IN(17)) { pg8::EpiResid E{xo, xo, DM, mods + 12288 + 10240, MODS_LD}; GEMM(pg8::EpiResid, ACT, (bf16*)(ws + WS_WFO) + (size_t)DM * DFF, DM, DFF, E); }
#undef IN
#undef SEAM
#undef GEMM
}

extern "C" void kernel_launch(void* const* d_in, const int* in_sizes, int n_in, void* d_out, int out_size, void* d_ws, size_t ws_size, hipStream_t stream) {
    static int grid = 0;
    if (grid == 0) {
        if (n_in != 21 || in_sizes[0] != M * DM || out_size != M * DM || ws_size < WS_END) { fprintf(stderr, "kernel_launch: unexpected shapes (n_in %d, in0 %d, out %d, ws %zu)\n", n_in, n_in > 0 ? in_sizes[0] : -1, out_size, ws_size); grid = -1; return; }
        int dev = 0, cus = 0, per_cu = 0;
        (void)hipGetDevice(&dev); (void)hipDeviceGetAttribute(&cus, hipDeviceAttributeMultiprocessorCount, dev);
        if (hipFuncSetAttribute((const void*)yoco_fwd, hipFuncAttributeMaxDynamicSharedMemorySize, LDS_BYTES) != hipSuccess) { fprintf(stderr, "kernel_launch: hipFuncSetAttribute failed\n"); grid = -1; return; }
        if (hipOccupancyMaxActiveBlocksPerMultiprocessor(&per_cu, (const void*)yoco_fwd, NWAVES * 64, LDS_BYTES) != hipSuccess || per_cu < 1) { fprintf(stderr, "kernel_launch: occupancy query says %d\n", per_cu); per_cu = 1; }
        (void)hipGetLastError();
        grid = cus > 0 ? cus : 256;
    }
    if (grid < 0) return;
    Args a{};
    for (int i = 0; i < 21; ++i) a.in[i] = (const float*)d_in[i];
    a.out = (float*)d_out; a.ws = (unsigned char*)d_ws;
#if MK_N_LAUNCHES == 1
    a.ph_lo = 0; a.ph_hi = NPHASE;
    void* args[] = {&a};
    hipError_t e = hipLaunchCooperativeKernel((const void*)yoco_fwd, dim3(grid), dim3(NWAVES * 64), args, LDS_BYTES, stream);
    if (e != hipSuccess) fprintf(stderr, "kernel_launch: cooperative launch failed: %s (grid %d)\n", hipGetErrorString(e), grid);
#else
    for (int p = 0; p < NPHASE; ++p) { a.ph_lo = p; a.ph_hi = p + 1; hipLaunchKernelGGL(yoco_fwd, dim3(grid), dim3(NWAVES * 64), LDS_BYTES, stream, a); }
#endif
}
```

```cpp
#include <hip/hip_runtime.h>
#include <hip/hip_cooperative_groups.h>
#include <cstdio>
#include <cstdint>
namespace cg = cooperative_groups;
namespace pg8 {
#define PG8_LAS __attribute__((address_space(3)))
typedef unsigned short bf16_t;
typedef short bf16x8 __attribute__((ext_vector_type(8)));
typedef float f32x4 __attribute__((ext_vector_type(4)));
typedef unsigned u32x4 __attribute__((ext_vector_type(4)));
constexpr int BM = 256, BK = 64, HALF = 128, HTB = HALF * BK * 2  , STAGE_BYTES = 8 * HTB, NXCD = 8, WGM = 4;

__host__ __device__ __forceinline__ int lds_byte(int r, int c) { const int st = (r >> 4) * 2 + (c >> 5), rr = r & 15, cc = c & 31, ob = rr * 64 + cc * 2; return st * 1024 + (ob ^ (((ob >> 9) & 1) << 5)); }
__host__ __device__ __forceinline__ void stage_rc(int b, int& R, int& C) { const int st = b / 1024, sb = b % 1024, swz = sb ^ (((sb >> 9) & 1) << 5); R = (st >> 1) * 16 + swz / 64; C = (st & 1) * 32 + (swz % 64) / 2; }
__host__ __device__ __forceinline__ int perm32(int rho) { const int n = rho >> 4, i = rho & 15; return 8 * (i >> 2) + 4 * n + (i & 3); }

struct Unit { int pm, pn, dry; };
struct Gemm { const bf16_t* A; const bf16_t* Bt; int M, N, K; };

struct StaticOrder {
    int nM, nN, nwg, G, c, rep;
    __host__ __device__ void init(int M, int N, int G_, int c_) { nM = M / BM; nN = N / BM; nwg = nM * nN; G = G_; c = c_; rep = 1; }
    __host__ __device__ bool next(int i, Unit& u) const {
        long L = (long)i * G + c; if (L >= (long)nwg * rep) return false; u.dry = 0; if (L >= nwg) { L -= nwg; u.dry = 1; }
        int wgid = (int)L; { const int q = nwg / NXCD, r = nwg % NXCD, xcd = wgid % NXCD, off = wgid / NXCD; wgid = (xcd < r ? xcd * (q + 1) : r * (q + 1) + (xcd - r) * q) + off; }
        const int nig = WGM * nN, gid = wgid / nig, fm = gid * WGM, gsz = (nM - fm) < WGM ? (nM - fm) : WGM;
        u.pm = fm + ((wgid % nig) % gsz); u.pn = (wgid % nig) / gsz; return true;
    }
    __device__ __forceinline__ void a_ready(const Unit&) const {}
    __device__ __forceinline__ void done(const Unit&) const {}
};

__device__ __forceinline__ unsigned cvt_pk_bf16(float lo, float hi) { unsigned r; asm volatile("v_cvt_pk_bf16_f32 %0, %1, %2" : "=v"(r) : "v"(lo), "v"(hi)); return r; }
template <bool ROPE, bool FUSED>
struct EpiStore {
    static constexpr bool PERM = true, AFTER_DRAIN = false;
    bf16_t* O; int ldc; int ftile; float* logf; const float* bf; int norm_tiles; const float* gains; int gsh; const float* rope; const float* rowss; const float* sw; int swpitch;
    __device__ __forceinline__ void operator()(const f32x4 (&acc_in)[2][2][4][2], const Unit& u, int wr, int wc, int fr_in, int fq_in, PG8_LAS unsigned char* lds) const {
        int fr = fr_in, fq = fq_in; asm volatile("" : "+v"(fr), "+v"(fq));
        const int row0 = u.pm * BM + wr * 64 + fr;
        float rstd[2][4]; f32x4 sv[2][2];
        if constexpr (FUSED) { const float* sp = sw + (size_t)(u.pm >> 3) * swpitch + u.pn * BM + wc * 32 + 8 * fq;
#pragma unroll
            for (int bj = 0; bj < 2; ++bj)
#pragma unroll
                for (int n = 0; n < 2; ++n) sv[bj][n] = *(const f32x4*)(sp + bj * HALF + 4 * n);
#pragma unroll
            for (int ai = 0; ai < 2; ++ai)
#pragma unroll
                for (int m = 0; m < 4; ++m) rstd[ai][m] = __builtin_amdgcn_rsqf(rowss[row0 + ai * HALF + m * 16] * (1.f / 2048.f) + 1e-6f);
        } else {
#pragma unroll
            for (int bj = 0; bj < 2; ++bj)
#pragma unroll
                for (int n = 0; n < 2; ++n) sv[bj][n] = (f32x4){0.f, 0.f, 0.f, 0.f};
#pragma unroll
            for (int ai = 0; ai < 2; ++ai)
#pragma unroll
                for (int m = 0; m < 4; ++m) rstd[ai][m] = 1.f;
        }
#define ACCV(ai, bj, m, n) (FUSED ? (acc_in[ai][bj][m][n] * rstd[ai][m] + sv[bj][n]) : acc_in[ai][bj][m][n])
        if (FUSED && u.pn >= ftile) {
            if (wc == 0 && fq < 2) {
#pragma unroll
                for (int ai = 0; ai < 2; ++ai)
#pragma unroll
                    for (int m = 0; m < 4; ++m) { const int row = row0 + ai * HALF + m * 16; float* rp = logf + ((size_t)(row >> 11) * 16 + 8 * fq) * 2048 + (row & 2047);
#pragma unroll
                        for (int n = 0; n < 2; ++n) { const f32x4 z = ACCV(ai, 0, m, n);
#pragma unroll
                            for (int j = 0; j < 4; ++j) rp[(size_t)(4 * n + j) * 2048] = z[j]; } }
            }
            return;
        }
        const bool nrm = u.pn < norm_tiles;
        float rs[2][4][2]; f32x4 gv[2][2];
        if (nrm) {
            PG8_LAS float* P = (PG8_LAS float*)(lds + STAGE_BYTES);
#pragma unroll
            for (int ai = 0; ai < 2; ++ai)
#pragma unroll
                for (int m = 0; m < 4; ++m)
#pragma unroll
                    for (int bj = 0; bj < 2; ++bj) { const f32x4 x0 = ACCV(ai, bj, m, 0), x1 = ACCV(ai, bj, m, 1);
                        float q = (x0[0] * x0[0] + x0[1] * x0[1]) + (x0[2] * x0[2] + x0[3] * x0[3]) + (x1[0] * x1[0] + x1[1] * x1[1]) + (x1[2] * x1[2] + x1[3] * x1[3]);
                        q += __shfl_xor(q, 16); q += __shfl_xor(q, 32);
                        if (fq == 0) P[((ai * HALF + wr * 64 + m * 16 + fr) * 2 + bj) * 4 + wc] = q; }
            asm volatile("s_waitcnt lgkmcnt(0)\n\ts_barrier" ::: "memory");
#pragma unroll
            for (int ai = 0; ai < 2; ++ai)
#pragma unroll
                for (int m = 0; m < 4; ++m)
#pragma unroll
                    for (int bj = 0; bj < 2; ++bj) { const f32x4 p = *(const PG8_LAS f32x4*)(P + ((ai * HALF + wr * 64 + m * 16 + fr) * 2 + bj) * 4);
                        rs[ai][m][bj] = __builtin_amdgcn_rsqf(((p[0] + p[1]) + (p[2] + p[3])) * (1.f / 128.f) + 1e-6f); }
#pragma unroll
            for (int bj = 0; bj < 2; ++bj) { const float* gp = gains + (size_t)((2 * u.pn + bj) >> gsh) * 128;
                if (ROPE && wc == 0) { gv[bj][0] = *(const f32x4*)(gp + 4 * fq); gv[bj][1] = *(const f32x4*)(gp + 4 * fq + 16); }
                else { gv[bj][0] = *(const f32x4*)(gp + wc * 32 + 8 * fq); gv[bj][1] = *(const f32x4*)(gp + wc * 32 + 8 * fq + 4); } }
        }
        const bool rp_on = ROPE && nrm && wc == 0;
        const int col0 = u.pn * BM + wc * 32 + 8 * fq;
#pragma unroll
        for (int ai = 0; ai < 2; ++ai) {
            f32x4 cs[4][2];
            if (rp_on) {
#pragma unroll
                for (int m = 0; m < 4; ++m) { const float* cp = rope + (size_t)((row0 + ai * HALF + m * 16) & 2047) * 16 + 4 * fq; cs[m][0] = *(const f32x4*)cp; cs[m][1] = *(const f32x4*)(cp + 2048 * 16); }
                asm volatile("" ::: "memory"); }
#pragma unroll
            for (int m = 0; m < 4; ++m) { const int row = row0 + ai * HALF + m * 16; bf16_t* rowp = O + (size_t)row * ldc + col0;
#pragma unroll
                for (int bj = 0; bj < 2; ++bj) { f32x4 v0 = ACCV(ai, bj, m, 0), v1 = ACCV(ai, bj, m, 1);
                    if (nrm) { v0 = v0 * rs[ai][m][bj] * gv[bj][0]; v1 = v1 * rs[ai][m][bj] * gv[bj][1]; }
                    if (rp_on) { const f32x4 x1 = v0, x2 = v1; v0 = x1 * cs[m][0] - x2 * cs[m][1]; v1 = x2 * cs[m][0] + x1 * cs[m][1]; }
                    u32x4 w; w.x = cvt_pk_bf16(v0[0], v0[1]); w.y = cvt_pk_bf16(v0[2], v0[3]); w.z = cvt_pk_bf16(v1[0], v1[1]); w.w = cvt_pk_bf16(v1[2], v1[3]);
                    *(u32x4*)(rowp + bj * HALF) = w; } }
        }
    }
#undef ACCV
};
struct EpiSwiglu {
    static constexpr bool PERM = true, AFTER_DRAIN = false;
    bf16_t* O; int ldc; const float* rowss; const float* sw; int swpitch;
    __device__ __forceinline__ void operator()(const f32x4 (&acc)[2][2][4][2], const Unit& u, int wr, int wc, int fr_in, int fq_in, PG8_LAS unsigned char* lds) const {
        int fr = fr_in, fq = fq_in; asm volatile("" : "+v"(fr), "+v"(fq));
        const int row0 = u.pm * BM + wr * 64 + fr, col0 = u.pn * HALF + wc * 32 + 8 * fq;
        f32x4 sv[2][2];
        { const float* sp = sw + (size_t)(u.pm >> 3) * swpitch + u.pn * BM + wc * 32 + 8 * fq;
#pragma unroll
          for (int bj = 0; bj < 2; ++bj)
#pragma unroll
              for (int n = 0; n < 2; ++n) sv[bj][n] = *(const f32x4*)(sp + bj * HALF + 4 * n); }
        float rsd[2][4];
#pragma unroll
        for (int ai = 0; ai < 2; ++ai)
#pragma unroll
            for (int m = 0; m < 4; ++m) rsd[ai][m] = rowss[row0 + ai * HALF + m * 16];
        asm volatile("" ::: "memory");
#pragma unroll
        for (int ai = 0; ai < 2; ++ai)
#pragma unroll
            for (int m = 0; m < 4; ++m) { const int row = row0 + ai * HALF + m * 16; bf16_t* rowp = O + (size_t)row * ldc + col0; float r[8];
                const float rstd = __builtin_amdgcn_rsqf(rsd[ai][m] * (1.f / 2048.f) + 1e-6f);
#pragma unroll
                for (int n = 0; n < 2; ++n)
#pragma unroll
                    for (int j = 0; j < 4; ++j) { const float g = fmaf(acc[ai][0][m][n][j], rstd, sv[0][n][j]), up = fmaf(acc[ai][1][m][n][j], rstd, sv[1][n][j]);
                        r[4 * n + j] = g * __builtin_amdgcn_rcpf(1.f + __builtin_amdgcn_exp2f(-1.4426950408889634f * g)) * up; }
                u32x4 w; w.x = cvt_pk_bf16(r[0], r[1]); w.y = cvt_pk_bf16(r[2], r[3]); w.z = cvt_pk_bf16(r[4], r[5]); w.w = cvt_pk_bf16(r[6], r[7]);
                *(u32x4*)rowp = w; }
    }
};
template <int NH, bool BIN, bool BOUT>
struct EpiResid {
    static constexpr bool PERM = true, AFTER_DRAIN = false, PREFETCH = false;
    const void* base; void* out; int ldc; const float* gate; int gpitch;
    float* rowss; const float* g1; const float* sc1; bf16_t* h1; const float* g2; const float* sc2; bf16_t* h2;
    __device__ __forceinline__ void operator()(const f32x4 (&acc)[2][2][4][2], const Unit& u, int wr, int wc, int fr_in, int fq_in, PG8_LAS unsigned char* lds) const {
        int fr = fr_in, fq = fq_in; asm volatile("" : "+v"(fr), "+v"(fq));
        const int row0 = u.pm * BM + wr * 64 + fr, col0 = u.pn * BM + wc * 32 + 8 * fq;
        const size_t boff = (size_t)(u.pm >> 3) * gpitch + col0;
        f32x4 gv[2][2], s1[2][2], s2[2][2];
#pragma unroll
        for (int bj = 0; bj < 2; ++bj)
#pragma unroll
            for (int n = 0; n < 2; ++n) { const int co = bj * HALF + 4 * n; gv[bj][n] = *(const f32x4*)(gate + boff + co);
                if (NH >= 1) s1[bj][n] = *(const f32x4*)(g1 + col0 + co) * (*(const f32x4*)(sc1 + boff + co) + 1.f);
                if (NH >= 2) s2[bj][n] = *(const f32x4*)(g2 + col0 + co) * (*(const f32x4*)(sc2 + boff + co) + 1.f); }
        constexpr int MB = (NH == 2) ? 2 : (BIN ? 4 : ((NH >= 1) ? 2 : 4));
#pragma unroll
        for (int am = 0; am < 8; am += MB) { const int ai = am >> 2;
            f32x4 bsv[MB][2][BIN ? 1 : 2];
#pragma unroll
            for (int mm = 0; mm < MB; ++mm) { const size_t off = (size_t)(row0 + ai * HALF + ((am & 3) + mm) * 16) * ldc + col0;
#pragma unroll
                for (int bj = 0; bj < 2; ++bj) {
                    if (BIN) bsv[mm][bj][0] = *(const f32x4*)((const bf16_t*)base + off + bj * HALF);
                    else {
#pragma unroll
                        for (int n = 0; n < (BIN ? 1 : 2); ++n) bsv[mm][bj][n] = *(const f32x4*)((const float*)base + off + bj * HALF + 4 * n); } } }
            asm volatile("" ::: "memory");
#pragma unroll
            for (int mm = 0; mm < MB; ++mm) { const int m = (am & 3) + mm; const int row = row0 + ai * HALF + m * 16; const size_t off = (size_t)row * ldc + col0; float q = 0.f;
#pragma unroll
                for (int bj = 0; bj < 2; ++bj) { f32x4 x[2];
                    if (BIN) { const u32x4 r = __builtin_bit_cast(u32x4, bsv[mm][bj][0]);
                        x[0] = (f32x4){__uint_as_float(r.x << 16), __uint_as_float(r.x & 0xffff0000u), __uint_as_float(r.y << 16), __uint_as_float(r.y & 0xffff0000u)};
                        x[1] = (f32x4){__uint_as_float(r.z << 16), __uint_as_float(r.z & 0xffff0000u), __uint_as_float(r.w << 16), __uint_as_float(r.w & 0xffff0000u)}; }
                    else { x[0] = bsv[mm][bj][0]; x[1] = bsv[mm][bj][BIN ? 0 : 1]; }
#pragma unroll
                    for (int n = 0; n < 2; ++n) { x[n] = x[n] + gv[bj][n] * acc[ai][bj][m][n];
                        q += (x[n][0] * x[n][0] + x[n][1] * x[n][1]) + (x[n][2] * x[n][2] + x[n][3] * x[n][3]); }
                    if (!u.dry) {
                        if (BOUT) { u32x4 w; w.x = cvt_pk_bf16(x[0][0], x[0][1]); w.y = cvt_pk_bf16(x[0][2], x[0][3]); w.z = cvt_pk_bf16(x[1][0], x[1][1]); w.w = cvt_pk_bf16(x[1][2], x[1][3]);
                            *(u32x4*)((bf16_t*)out + off + bj * HALF) = w; }
                        else { *(f32x4*)((float*)out + off + bj * HALF) = x[0]; *(f32x4*)((float*)out + off + bj * HALF + 4) = x[1]; } }
                    if (NH >= 1) { const f32x4 a0 = x[0] * s1[bj][0], a1 = x[1] * s1[bj][1]; u32x4 w; w.x = cvt_pk_bf16(a0[0], a0[1]); w.y = cvt_pk_bf16(a0[2], a0[3]); w.z = cvt_pk_bf16(a1[0], a1[1]); w.w = cvt_pk_bf16(a1[2], a1[3]);
                        if (!u.dry) *(u32x4*)(h1 + off + bj * HALF) = w; }
                    if (NH >= 2) { const f32x4 a0 = x[0] * s2[bj][0], a1 = x[1] * s2[bj][1]; u32x4 w; w.x = cvt_pk_bf16(a0[0], a0[1]); w.y = cvt_pk_bf16(a0[2], a0[3]); w.z = cvt_pk_bf16(a1[0], a1[1]); w.w = cvt_pk_bf16(a1[2], a1[3]);
                        if (!u.dry) *(u32x4*)(h2 + off + bj * HALF) = w; } }
                if (NH >= 1) { q += __shfl_xor(q, 16); q += __shfl_xor(q, 32); if (fq == 0 && !u.dry) __hip_atomic_fetch_add(rowss + row, q, __ATOMIC_RELAXED, __HIP_MEMORY_SCOPE_AGENT); } }
            asm volatile("" ::: "memory");
        }
    }
};
template <class Epi, class Sched, bool ALIGN_EPI = false, bool SP2 = false>
__device__ __forceinline__ void gemm_phase(PG8_LAS unsigned char* lds, const Gemm g, const Sched& S, const Epi& E) {
    const int tid = threadIdx.x, wid = __builtin_amdgcn_readfirstlane(tid >> 6), lane = tid & 63, wr = wid >> 2, wc = wid & 3, fr = lane & 15, fq = lane >> 4;
    const int K = g.K, nt = K / BK;
    unsigned voffA[2], voffB[2];
#pragma unroll
    for (int i = 0; i < 2; ++i) { int R, C; stage_rc(tid * 16 + i * 8192, R, C); const int Rb = Epi::PERM ? ((R & ~31) + perm32(R & 31)) : R;
        voffA[i] = (unsigned)(R * K + C) * 2u; voffB[i] = (unsigned)(Rb * K + C) * 2u; }
    const size_t kstep = (size_t)(BK * 2);
    const size_t hstep = (size_t)HALF * K * 2;
    const size_t tstep = 2 * hstep;
    const unsigned ldsw = (unsigned)wid * 1024u;
    const int aoff = lds_byte(wr * 64 + fr, fq * 8), boff = lds_byte(wc * 32 + fr, fq * 8);
#define PG8_SA(b, h) (((b) * 2 + (h)) * HTB)
#define PG8_SB(b, h) ((4 + (b) * 2 + (h)) * HTB)
#define PG8_STAGE(bufoff, gbase, voff) do { _Pragma("unroll") for (int _i = 0; _i < 2; ++_i) \
        __builtin_amdgcn_global_load_lds((const unsigned*)((const char*)(gbase) + (voff)[_i]), (PG8_LAS unsigned*)(lds + (bufoff) + ldsw + _i * 8192), 16, 0, 0); } while (0)
#define PG8_LDA(dst, b, h) do { _Pragma("unroll") for (int m = 0; m < 4; ++m) _Pragma("unroll") for (int k = 0; k < 2; ++k) dst[m][k] = *(const PG8_LAS bf16x8*)(lds + PG8_SA(b, h) + aoff + m * 2048 + k * 1024); } while (0)
#define PG8_LDB(dst, b, h) do { _Pragma("unroll") for (int n = 0; n < 2; ++n) _Pragma("unroll") for (int k = 0; k < 2; ++k) dst[n][k] = *(const PG8_LAS bf16x8*)(lds + PG8_SB(b, h) + boff + n * 2048 + k * 1024); } while (0)
#define PG8_MMA(ai, bj, At, Bt) do { __builtin_amdgcn_s_setprio(1); _Pragma("unroll") for (int m = 0; m < 4; ++m) _Pragma("unroll") for (int n = 0; n < 2; ++n) _Pragma("unroll") for (int k = 0; k < 2; ++k) \
        acc[ai][bj][m][n] = __builtin_amdgcn_mfma_f32_16x16x32_bf16(Bt[n][k], At[m][k], acc[ai][bj][m][n], 0, 0, 0); __builtin_amdgcn_s_setprio(0); } while (0)
#define PG8_WAIT_V(n) asm volatile("s_waitcnt vmcnt(" #n ")" ::: "memory")
#define PG8_WAIT_L(n) asm volatile("s_waitcnt lgkmcnt(" #n ")" ::: "memory")
#define PG8_BAR __builtin_amdgcn_s_barrier()
#define PG8_SCHED __builtin_amdgcn_sched_barrier(0)
    Unit cur, nxt; int ui = 0;
    if (!S.next(0, cur)) return;
    f32x4 acc[2][2][4][2];
#pragma unroll
    for (int a = 0; a < 2; ++a)
#pragma unroll
        for (int b = 0; b < 2; ++b)
#pragma unroll
            for (int m = 0; m < 4; ++m)
#pragma unroll
                for (int n = 0; n < 2; ++n) acc[a][b][m][n] = (f32x4){0.f, 0.f, 0.f, 0.f};
    bf16x8 At[4][2], B0[2][2], B1[2][2];
    const char* cA = (const char*)g.A + (size_t)cur.pm * tstep; const char* cB = (const char*)g.Bt + (size_t)cur.pn * tstep;
    S.a_ready(cur);
    if constexpr (SP2) {
        PG8_STAGE(PG8_SB(0, 0), cB, voffB); PG8_STAGE(PG8_SB(0, 1), cB + hstep, voffB); PG8_STAGE(PG8_SA(0, 0), cA, voffA); PG8_STAGE(PG8_SA(0, 1), cA + hstep, voffA);
        if (wr == 1) PG8_BAR;
        PG8_WAIT_V(2); PG8_BAR;
        PG8_STAGE(PG8_SB(1, 0), cB + kstep, voffB); PG8_STAGE(PG8_SA(1, 0), cA + kstep, voffA); PG8_STAGE(PG8_SB(1, 1), cB + hstep + kstep, voffB);
        PG8_WAIT_V(6); PG8_BAR;
    } else {
        PG8_STAGE(PG8_SB(0, 0), cB, voffB); PG8_STAGE(PG8_SA(0, 0), cA, voffA); PG8_STAGE(PG8_SB(0, 1), cB + hstep, voffB); PG8_STAGE(PG8_SA(0, 1), cA + hstep, voffA);
        if (wr == 1) PG8_BAR;
        PG8_WAIT_V(4); PG8_BAR;
        PG8_STAGE(PG8_SB(1, 0), cB + kstep, voffB); PG8_STAGE(PG8_SA(1, 0), cA + kstep, voffA); PG8_STAGE(PG8_SB(1, 1), cB + hstep + kstep, voffB);
        PG8_WAIT_V(6); PG8_BAR;
    }
    for (;;) {
        const bool has_next = S.next(ui + 1, nxt);
        const char* nA = has_next ? (const char*)g.A + (size_t)nxt.pm * tstep : cA; const char* nB = has_next ? (const char*)g.Bt + (size_t)nxt.pn * tstep : cB;
        for (int t = 0; t < nt; t += 2) {
            const bool last = (t == nt - 2);
            const char* a1 = cA + (size_t)(t + 1) * kstep;
            const char* a2 = last ? nA : cA + (size_t)(t + 2) * kstep; const char* b2 = last ? nB : cB + (size_t)(t + 2) * kstep;
            const char* a3 = a2 + kstep; const char* b3 = b2 + kstep;
            if (last && has_next) S.a_ready(nxt);
            if constexpr (SP2) {
            PG8_LDB(B0, 0, 0); PG8_LDB(B1, 0, 1); PG8_SCHED; PG8_LDA(At, 0, 0); PG8_STAGE(PG8_SA(1, 1), a1 + hstep, voffA);
            PG8_WAIT_V(8); PG8_WAIT_L(0); PG8_BAR; PG8_MMA(0, 0, At, B0); PG8_MMA(0, 1, At, B1); PG8_BAR; PG8_SCHED;
            PG8_LDA(At, 0, 1); PG8_STAGE(PG8_SB(0, 0), b2, voffB); PG8_STAGE(PG8_SB(0, 1), b2 + hstep, voffB); PG8_STAGE(PG8_SA(0, 0), a2, voffA);
            PG8_WAIT_V(8); PG8_WAIT_L(0); PG8_BAR; PG8_MMA(1, 0, At, B0); PG8_MMA(1, 1, At, B1); PG8_BAR; PG8_SCHED;
            PG8_LDB(B0, 1, 0); PG8_LDB(B1, 1, 1); PG8_SCHED; PG8_LDA(At, 1, 0); PG8_STAGE(PG8_SA(0, 1), a2 + hstep, voffA);
            PG8_WAIT_V(8); PG8_WAIT_L(0); PG8_BAR; PG8_MMA(0, 0, At, B0); PG8_MMA(0, 1, At, B1); PG8_BAR; PG8_SCHED;
            PG8_LDA(At, 1, 1); PG8_STAGE(PG8_SB(1, 0), b3, voffB); PG8_STAGE(PG8_SB(1, 1), b3 + hstep, voffB); PG8_STAGE(PG8_SA(1, 0), a3, voffA);
            PG8_WAIT_V(8); PG8_WAIT_L(0); PG8_BAR; PG8_MMA(1, 0, At, B0); PG8_MMA(1, 1, At, B1); PG8_BAR; PG8_SCHED;
            } else {
            PG8_LDB(B0, 0, 0); PG8_SCHED; PG8_LDA(At, 0, 0); PG8_STAGE(PG8_SA(1, 1), a1 + hstep, voffA);
            PG8_WAIT_L(8); PG8_BAR; PG8_WAIT_L(0); PG8_MMA(0, 0, At, B0); PG8_BAR; PG8_SCHED;
            PG8_LDB(B1, 0, 1); PG8_STAGE(PG8_SB(0, 0), b2, voffB);
            PG8_BAR; PG8_WAIT_L(0); PG8_MMA(0, 1, At, B1); PG8_BAR;
            PG8_LDA(At, 0, 1); PG8_STAGE(PG8_SA(0, 0), a2, voffA);
            PG8_BAR; PG8_WAIT_L(0); PG8_MMA(1, 0, At, B0); PG8_BAR; PG8_SCHED;
            PG8_STAGE(PG8_SB(0, 1), b2 + hstep, voffB);
            PG8_WAIT_V(6); PG8_BAR; PG8_MMA(1, 1, At, B1); PG8_BAR;
            PG8_LDB(B0, 1, 0); PG8_SCHED; PG8_LDA(At, 1, 0); PG8_STAGE(PG8_SA(0, 1), a2 + hstep, voffA);
            PG8_WAIT_L(8); PG8_BAR; PG8_WAIT_L(0); PG8_MMA(0, 0, At, B0); PG8_BAR; PG8_SCHED;
            PG8_LDB(B1, 1, 1); PG8_STAGE(PG8_SB(1, 0), b3, voffB);
            PG8_BAR; PG8_WAIT_L(0); PG8_MMA(0, 1, At, B1); PG8_BAR;
            PG8_LDA(At, 1, 1); PG8_STAGE(PG8_SA(1, 0), a3, voffA);
            PG8_BAR; PG8_WAIT_L(0); PG8_MMA(1, 0, At, B0); PG8_BAR; PG8_SCHED;
            PG8_STAGE(PG8_SB(1, 1), b3 + hstep, voffB);
            PG8_WAIT_V(6); PG8_BAR; PG8_MMA(1, 1, At, B1); PG8_BAR;
            }
        }
        if constexpr (ALIGN_EPI) { if (wr == 0) PG8_BAR; }
        if constexpr (!Epi::AFTER_DRAIN) { E(acc, cur, wr, wc, fr, fq, lds); S.done(cur); }
        if (!has_next) break;
#pragma unroll
        for (int a = 0; a < 2; ++a)
#pragma unroll
            for (int b = 0; b < 2; ++b)
#pragma unroll
                for (int m = 0; m < 4; ++m)
#pragma unroll
                    for (int n = 0; n < 2; ++n) acc[a][b][m][n] = (f32x4){0.f, 0.f, 0.f, 0.f};
        cur = nxt; cA = nA; cB = nB; ++ui;
        if constexpr (ALIGN_EPI) { if (wr == 1) PG8_BAR; }
    }
    PG8_WAIT_V(0);
    if constexpr (!ALIGN_EPI) { if (wr == 0) PG8_BAR; }
    PG8_BAR;
    if constexpr (Epi::AFTER_DRAIN) { E.fused(acc, cur, wr, wc, fr, fq, lds, wid, lane); S.done(cur); }
#undef PG8_SA
#undef PG8_SB
#undef PG8_STAGE
#undef PG8_LDA
#undef PG8_LDB
#undef PG8_MMA
#undef PG8_WAIT_V
#undef PG8_WAIT_L
#undef PG8_BAR
#undef PG8_SCHED
}
}

namespace att {
#define ALAS __attribute__((address_space(3)))
typedef unsigned short bf16_t;
typedef short bf16x8 __attribute__((ext_vector_type(8)));
typedef short s16x4 __attribute__((ext_vector_type(4)));
typedef float f32x16 __attribute__((ext_vector_type(16)));
typedef float f32x4 __attribute__((ext_vector_type(4)));
typedef unsigned u32x4 __attribute__((ext_vector_type(4)));
constexpr int KVBLK = 64, QBLK = 32, SHM_K = 16384, SHM_V = 16384;
constexpr int GRP_BYTES = 2 * SHM_V + 2 * SHM_K + 512;
constexpr int SCR_OFF = 2 * GRP_BYTES;
constexpr int LDS_NEED = SCR_OFF + 8 * 256;
constexpr float SCALE = 0.08838834764831845f, THR = 8.f;
#define KSWZ(row, colB) ((row) * 256 + ((colB) ^ (((row) & 7) << 4)))
#define SBAR() __builtin_amdgcn_sched_barrier(0)
__device__ __forceinline__ int v_st(int k, int c) { const int kk = (k & ~0xC) | ((k & 4) << 1) | ((k & 8) >> 1); return ((kk >> 3) * 4 + (c >> 5)) * 512 + ((kk & 7) * 32 + (c & 31)) * 2; }
__device__ __forceinline__ int v_rd_base(int lane) { return ((lane & 3) << 3) | (((lane >> 2) & 3) << 6) | (((lane >> 4) & 1) << 5) | (((lane >> 5) & 1) << 8); }
__device__ __forceinline__ int crow(int r, int hi) { return (r & 3) + 8 * (r >> 2) + 4 * hi; }
__device__ __forceinline__ unsigned cvtpk(float lo, float hi) { unsigned r; asm volatile("v_cvt_pk_bf16_f32 %0, %1, %2" : "=v"(r) : "v"(lo), "v"(hi)); return r; }
__device__ __forceinline__ void mask_tile(f32x16& p0, f32x16& p1, int dq, unsigned W) {
    const float NEG = -__builtin_inff();
#pragma unroll
    for (int r = 0; r < 16; ++r) { const int c = (r & 3) + 8 * (r >> 2);
        if ((unsigned)(dq - c) >= W) p0[r] = NEG;
        if ((unsigned)(dq - c - 32) >= W) p1[r] = NEG; }
}
__device__ __forceinline__ void partialSM(f32x16& p0, f32x16& p1, float& m_reg, float& mn, float& alpha) {
    float pmax = p0[0];
#pragma unroll
    for (int r = 1; r < 16; ++r) pmax = fmaxf(pmax, p0[r]);
#pragma unroll
    for (int r = 0; r < 16; ++r) pmax = fmaxf(pmax, p1[r]);
    { auto rr = __builtin_amdgcn_permlane32_swap(__float_as_uint(pmax), __float_as_uint(pmax), false, false);
      pmax = fmaxf(__uint_as_float(rr[0]), __uint_as_float(rr[1])); }
    constexpr float C2 = 1.4426950408889634f * SCALE;
    if (__builtin_expect(__all((pmax - m_reg) * SCALE <= THR), 1)) { mn = m_reg; alpha = 1.f; }
    else { mn = fmaxf(m_reg, pmax); alpha = __builtin_amdgcn_exp2f((m_reg - mn) * C2); m_reg = mn; }
    const float mnL = -mn * C2;
#pragma unroll
    for (int r = 0; r < 16; ++r) p0[r] = fmaf(p0[r], C2, mnL);
#pragma unroll
    for (int r = 0; r < 16; ++r) p1[r] = fmaf(p1[r], C2, mnL);
#pragma unroll
    for (int r = 0; r < 16; ++r) p0[r] = __builtin_amdgcn_exp2f(p0[r]);
}
__device__ __forceinline__ void finishSM(f32x16& p0, f32x16& p1, float alpha, float& l_reg, bf16x8& pa0, bf16x8& pa1, bf16x8& pa2, bf16x8& pa3) {
#pragma unroll
    for (int r = 0; r < 16; ++r) p1[r] = __builtin_amdgcn_exp2f(p1[r]);
    float ps = 0;
#pragma unroll
    for (int r = 0; r < 16; ++r) ps += p0[r];
#pragma unroll
    for (int r = 0; r < 16; ++r) ps += p1[r];
    { auto rr = __builtin_amdgcn_permlane32_swap(__float_as_uint(ps), __float_as_uint(ps), false, false);
      ps = __uint_as_float(rr[0]) + __uint_as_float(rr[1]); }
    l_reg = l_reg * alpha + ps;
#define PK4(P, B_, OUT) do { unsigned a0 = cvtpk(P[B_+0], P[B_+1]), a1 = cvtpk(P[B_+2], P[B_+3]);                          \
        unsigned b0 = cvtpk(P[B_+4], P[B_+5]), b1 = cvtpk(P[B_+6], P[B_+7]);                                             \
        auto r0 = __builtin_amdgcn_permlane32_swap(a0, b0, false, false); auto r1 = __builtin_amdgcn_permlane32_swap(a1, b1, false, false); \
        u32x4 w = {r0[0], r1[0], r0[1], r1[1]}; OUT = __builtin_bit_cast(bf16x8, w); } while (0)
    PK4(p0, 0, pa0); PK4(p0, 8, pa1); PK4(p1, 0, pa2); PK4(p1, 8, pa3);
#undef PK4
}
__device__ __forceinline__ void qkt(f32x16& p0, f32x16& p1, const ALAS char* Kb, int r32, int hi, const bf16x8* qr) {
    p0 = f32x16{}; p1 = f32x16{};
    const ALAS char* kb[4];
#pragma unroll
    for (int dd = 0; dd < 4; ++dd) kb[dd] = Kb + KSWZ(r32, (dd * 16 + hi * 8) * 2);
#pragma unroll
    for (int d0 = 0; d0 < 8; ++d0) { const ALAS char* a = kb[d0 & 3] + (d0 >> 2) * 128;
        const bf16x8 b0 = *(const ALAS bf16x8*)a;
        const bf16x8 b1 = *(const ALAS bf16x8*)(a + 32 * 256);
        p0 = __builtin_amdgcn_mfma_f32_32x32x16_bf16(b0, qr[d0], p0, 0, 0, 0);
        p1 = __builtin_amdgcn_mfma_f32_32x32x16_bf16(b1, qr[d0], p1, 0, 0, 0); }
}
__device__ __forceinline__ void pv_tile(f32x16* o, int vb0, bf16x8 pa0, bf16x8 pa1, bf16x8 pa2, bf16x8 pa3) {
#define TRRD(dst, off) asm volatile("ds_read_b64_tr_b16 %0, %1 offset:%2" : "=&v"(dst) : "v"(vb0), "i"(off) : "memory")
#define PV_KS(ks, pa) do { s16x4 l0, l1, l2, l3, h0, h1, h2, h3; constexpr int b_ = (ks) * 4096;   \
        TRRD(l0, b_); TRRD(h0, b_ + 2048); TRRD(l1, b_ + 512); TRRD(h1, b_ + 512 + 2048); TRRD(l2, b_ + 1024); TRRD(h2, b_ + 1024 + 2048); TRRD(l3, b_ + 1536); TRRD(h3, b_ + 1536 + 2048); \
        asm volatile("s_waitcnt lgkmcnt(0)" ::: "memory"); SBAR();   \
        o[0] = __builtin_amdgcn_mfma_f32_32x32x16_bf16(pa, (bf16x8){l0[0], l0[1], l0[2], l0[3], h0[0], h0[1], h0[2], h0[3]}, o[0], 0, 0, 0);   \
        o[1] = __builtin_amdgcn_mfma_f32_32x32x16_bf16(pa, (bf16x8){l1[0], l1[1], l1[2], l1[3], h1[0], h1[1], h1[2], h1[3]}, o[1], 0, 0, 0);   \
        o[2] = __builtin_amdgcn_mfma_f32_32x32x16_bf16(pa, (bf16x8){l2[0], l2[1], l2[2], l2[3], h2[0], h2[1], h2[2], h2[3]}, o[2], 0, 0, 0);   \
        o[3] = __builtin_amdgcn_mfma_f32_32x32x16_bf16(pa, (bf16x8){l3[0], l3[1], l3[2], l3[3], h3[0], h3[1], h3[2], h3[3]}, o[3], 0, 0, 0); } while (0)
    PV_KS(0, pa0); PV_KS(1, pa1); PV_KS(2, pa2); PV_KS(3, pa3);
#undef PV_KS
#undef TRRD
}
struct Unit { const bf16_t* Q; const bf16_t* K; const bf16_t* V; bf16_t* O; long ldq, ldk; int P0, W, j_lo, NT; float* lse; long lse_ld; int dry; };
constexpr int FB_OFF = LDS_NEED;
template <bool SHARED, bool BIAS>
__device__ __forceinline__ void attn_unit(const Unit& U, ALAS char* lds) {
    const int tid = threadIdx.x, wid = __builtin_amdgcn_readfirstlane(tid >> 6), lane = tid & 63, r32 = lane & 31, hi = lane >> 5;
    const int grp = SHARED ? 0 : (wid >> 2), gw = SHARED ? wid : (wid & 3), gtid = SHARED ? tid : (tid & 255);
    ALAS char* V_lds = lds + grp * GRP_BYTES; ALAS char* K_lds = V_lds + 2 * SHM_V;
    ALAS float* ws = (ALAS float*)(lds + SCR_OFF) + wid * 64; ALAS float* li_l = ws; ALAS float* al_l = ws + 32;
    constexpr int NST = SHARED ? 2 : 4, RSTEP = SHARED ? 32 : 16;
    const int sr = gtid >> 4, sc = (gtid & 15) * 8;
    bf16x8 qr[8];
    { const unsigned qoff = (unsigned)(gw * QBLK + r32) * (unsigned)U.ldq + hi * 8;
#pragma unroll
      for (int d0 = 0; d0 < 8; ++d0) qr[d0] = *(const bf16x8*)(U.Q + (qoff + d0 * 16)); }
    bf16x8 stk[NST], stv[NST];
    const unsigned soff = (unsigned)sr * (unsigned)U.ldk + sc, sstep = (unsigned)RSTEP * (unsigned)U.ldk;
#define LOADT(t) do { const size_t k0_ = (size_t)(U.j_lo + (t)) * KVBLK; const bf16_t* kt_ = U.K + k0_ * U.ldk; const bf16_t* vt_ = U.V + k0_ * U.ldk; \
        _Pragma("unroll") for (int i = 0; i < NST; ++i) { stk[i] = *(const bf16x8*)(kt_ + (soff + i * sstep)); stv[i] = *(const bf16x8*)(vt_ + (soff + i * sstep)); } \
        } while (0)
#define WRITET(bf) do { _Pragma("unroll") for (int i = 0; i < NST; ++i) { const int row_ = sr + i * RSTEP; \
        *(ALAS bf16x8*)(K_lds + (bf) * SHM_K + KSWZ(row_, sc * 2)) = stk[i]; *(ALAS bf16x8*)(V_lds + (bf) * SHM_V + v_st(row_, sc)) = stv[i]; } \
        } while (0)
    LOADT(0); WRITET(0);
    if (U.NT > 1) LOADT(1);
    const int qlo = U.P0 + gw * QBLK, qm = qlo + r32 - 4 * hi;
    float m_reg = -1e30f, l_reg = 0.f; f32x16 o[4] = {};
    const int vbase = (int)(uintptr_t)V_lds + v_rd_base(lane);
    for (int t = 0; t < U.NT; ++t) {
        asm volatile("s_waitcnt lgkmcnt(0)\n\ts_barrier" ::: "memory");
        const int bf = t & 1;
        if (t + 1 < U.NT) WRITET(bf ^ 1);
        if (t + 2 < U.NT) LOADT(t + 2);
        const int kb = (U.j_lo + t) * KVBLK;
        const bool act = (kb <= qlo + QBLK - 1) && (kb + KVBLK - 1 >= qlo - U.W + 1);
        if (act) {
            f32x16 p0, p1; float mn, alpha; bf16x8 pa0, pa1, pa2, pa3;
            qkt(p0, p1, K_lds + bf * SHM_K, r32, hi, qr);
            if (BIAS) { const ALAS char* bp = lds + FB_OFF + kb * 4 + hi * 16;
#pragma unroll
                for (int g = 0; g < 4; ++g) { const f32x4 b0 = *(const ALAS f32x4*)(bp + g * 32), b1 = *(const ALAS f32x4*)(bp + 128 + g * 32);
#pragma unroll
                    for (int j = 0; j < 4; ++j) { p0[4 * g + j] += b0[j]; p1[4 * g + j] += b1[j]; } } }
            if (kb + KVBLK - 1 > qlo || kb <= qlo + QBLK - 1 - U.W) mask_tile(p0, p1, qm - kb, (unsigned)U.W);
            partialSM(p0, p1, m_reg, mn, alpha);
            if (__any(alpha < 1.f)) { if (hi == 0) al_l[r32] = alpha; asm volatile("s_waitcnt lgkmcnt(0)" ::: "memory");
#pragma unroll
                for (int d_ = 0; d_ < 4; ++d_)
#pragma unroll
                    for (int r = 0; r < 16; ++r) o[d_][r] *= al_l[crow(r, hi)]; }
            finishSM(p0, p1, alpha, l_reg, pa0, pa1, pa2, pa3); SBAR();
            pv_tile(o, vbase + bf * SHM_V, pa0, pa1, pa2, pa3);
        }
    }
    if (hi == 0) { li_l[r32] = l_reg; if (U.lse && !U.dry) U.lse[(size_t)(gw * QBLK + r32) * U.lse_ld] = m_reg * SCALE + __logf(l_reg); }
    asm volatile("s_waitcnt lgkmcnt(0)" ::: "memory");
    float rli[16];
#pragma unroll
    for (int r = 0; r < 16; ++r) rli[r] = __builtin_amdgcn_rcpf(li_l[crow(r, hi)]);
    const unsigned ooff = (unsigned)(gw * QBLK + 4 * hi) * (unsigned)U.ldq + r32;
#pragma unroll
    for (int r = 0; r < 16; ++r) { const unsigned orow = (r & 3) + 8 * (r >> 2);
#pragma unroll
        for (int d0 = 0; d0 < 4; ++d0) { const float v = o[d0][r] * rli[r]; const float vn = __shfl_xor(v, 1);
            if ((r32 & 1) == 0 && !U.dry) *(unsigned*)(U.O + (ooff + orow * (unsigned)U.ldq + d0 * 32)) = cvtpk(v, vn); } }
    asm volatile("s_waitcnt lgkmcnt(0)\n\ts_barrier" ::: "memory");
#undef LOADT
#undef WRITET
}
template <bool BIAS>
__device__ __forceinline__ void attn_unit_pipe(const Unit& U, ALAS char* lds) {
    int tid = threadIdx.x; asm volatile("" : "+v"(tid));
    const int wid = __builtin_amdgcn_readfirstlane(tid >> 6), lane = tid & 63, r32 = lane & 31, hi = lane >> 5;
    ALAS char* V_lds = lds; ALAS char* K_lds = lds + 2 * SHM_V;
    ALAS float* ws = (ALAS float*)(lds + SCR_OFF) + wid * 64; ALAS float* li_l = ws; ALAS float* al_l = ws + 32;
    constexpr int NST = 2, RSTEP = 32;
    const int sr = tid >> 4, sc = (tid & 15) * 8;
    bf16x8 qr[8];
    { const unsigned qoff = (unsigned)(wid * QBLK + r32) * (unsigned)U.ldq + hi * 8;
#pragma unroll
      for (int d0 = 0; d0 < 8; ++d0) qr[d0] = *(const bf16x8*)(U.Q + (qoff + d0 * 16)); }
    bf16x8 stk[NST], stv[NST];
    const unsigned soff = (unsigned)sr * (unsigned)U.ldk + sc, sstep = (unsigned)RSTEP * (unsigned)U.ldk;
#define LOADT(t) do { const size_t k0_ = (size_t)(U.j_lo + (t)) * KVBLK; const bf16_t* kt_ = U.K + k0_ * U.ldk; const bf16_t* vt_ = U.V + k0_ * U.ldk; \
        _Pragma("unroll") for (int i = 0; i < NST; ++i) { stk[i] = *(const bf16x8*)(kt_ + (soff + i * sstep)); stv[i] = *(const bf16x8*)(vt_ + (soff + i * sstep)); } \
        } while (0)
#define WRITET(slot) do { _Pragma("unroll") for (int i = 0; i < NST; ++i) { const int row_ = sr + i * RSTEP; \
        *(ALAS bf16x8*)(K_lds + (slot) * SHM_K + KSWZ(row_, sc * 2)) = stk[i]; *(ALAS bf16x8*)(V_lds + (slot) * SHM_V + v_st(row_, sc)) = stv[i]; } \
        } while (0)
#define BARRIER() asm volatile("s_waitcnt lgkmcnt(0)\n\ts_barrier" ::: "memory")
    const int NT = U.NT;
    const int qlo = U.P0 + wid * QBLK, qm = qlo + r32 - 4 * hi;
    float m_reg = -1e30f, l_reg = 0.f; f32x16 o[4] = {};
    const int vbase = (int)(uintptr_t)V_lds + v_rd_base(lane);
#define KBASE(t) ((U.j_lo + (t)) * KVBLK)
#define ACTT(t) ((KBASE(t) <= qlo + QBLK - 1) && (KBASE(t) + KVBLK - 1 >= qlo - U.W + 1))
#define QKT(P0_, P1_, t) do { if (ACTT(t)) qkt(P0_, P1_, K_lds + ((t) & 1) * SHM_K, r32, hi, qr); else { const float NEG_ = -__builtin_inff(); \
        _Pragma("unroll") for (int r = 0; r < 16; ++r) { P0_[r] = NEG_; P1_[r] = NEG_; } } } while (0)
#define BMASK(P0_, P1_, t) do { if (ACTT(t)) { const int kb_ = KBASE(t); \
        if (BIAS) { const ALAS char* bp = lds + FB_OFF + kb_ * 4 + hi * 16; \
            _Pragma("unroll") for (int g = 0; g < 4; ++g) { const f32x4 b0 = *(const ALAS f32x4*)(bp + g * 32), b1 = *(const ALAS f32x4*)(bp + 128 + g * 32); \
                _Pragma("unroll") for (int j = 0; j < 4; ++j) { P0_[4 * g + j] += b0[j]; P1_[4 * g + j] += b1[j]; } } } \
        if (kb_ + KVBLK - 1 > qlo || kb_ <= qlo + QBLK - 1 - U.W) mask_tile(P0_, P1_, qm - kb_, (unsigned)U.W); } } while (0)
#define RESC(a) do { if (__any((a) < 1.f)) { if (hi == 0) al_l[r32] = (a); asm volatile("s_waitcnt lgkmcnt(0)" ::: "memory"); \
        _Pragma("unroll") for (int d_ = 0; d_ < 4; ++d_) _Pragma("unroll") for (int r = 0; r < 16; ++r) o[d_][r] *= al_l[crow(r, hi)]; } } while (0)
    f32x16 pA0, pA1, pB0, pB1; float mnA, mnB, alA, alB; bf16x8 pa0, pa1, pa2, pa3;
    LOADT(0); WRITET(0); BARRIER();
    LOADT(1);
    QKT(pA0, pA1, 0); BMASK(pA0, pA1, 0); partialSM(pA0, pA1, m_reg, mnA, alA);
    WRITET(1); BARRIER();
    if (NT > 2) LOADT(2);
#define HALF_STEP(PX0, PX1, mnX, alX, PY0, PY1, alY, t) do { \
        SBAR(); QKT(PX0, PX1, t); \
        finishSM(PY0, PY1, alY, l_reg, pa0, pa1, pa2, pa3); SBAR(); \
        if (ACTT((t) - 1)) pv_tile(o, vbase + (((t) - 1) & 1) * SHM_V, pa0, pa1, pa2, pa3); \
        BMASK(PX0, PX1, t); partialSM(PX0, PX1, m_reg, mnX, alX); \
        BARRIER(); \
        if ((t) + 1 < NT) { WRITET(((t) + 1) & 1); if ((t) + 2 < NT) LOADT((t) + 2); } \
        RESC(alX); BARRIER(); } while (0)
    for (int t = 1; t + 1 < NT; t += 2) {
        HALF_STEP(pB0, pB1, mnB, alB, pA0, pA1, alA, t);
        HALF_STEP(pA0, pA1, mnA, alA, pB0, pB1, alB, t + 1);
    }
    HALF_STEP(pB0, pB1, mnB, alB, pA0, pA1, alA, NT - 1);
    finishSM(pB0, pB1, alB, l_reg, pa0, pa1, pa2, pa3); SBAR();
    if (ACTT(NT - 1)) pv_tile(o, vbase + ((NT - 1) & 1) * SHM_V, pa0, pa1, pa2, pa3);
#undef HALF_STEP
#undef RESC
#undef BMASK
#undef QKT
#undef ACTT
#undef KBASE
    if (hi == 0) li_l[r32] = l_reg;
    asm volatile("s_waitcnt lgkmcnt(0)" ::: "memory");
    float rli[16];
#pragma unroll
    for (int r = 0; r < 16; ++r) rli[r] = __builtin_amdgcn_rcpf(li_l[crow(r, hi)]);
    const unsigned ooff = (unsigned)(wid * QBLK + 4 * hi) * (unsigned)U.ldq + r32;
#pragma unroll
    for (int r = 0; r < 16; ++r) { const unsigned orow = (r & 3) + 8 * (r >> 2);
#pragma unroll
        for (int d0 = 0; d0 < 4; ++d0) { const float v = o[d0][r] * rli[r]; const float vn = __shfl_xor(v, 1);
            if ((r32 & 1) == 0 && !U.dry) *(unsigned*)(U.O + (ooff + orow * (unsigned)U.ldq + d0 * 32)) = cvtpk(v, vn); } }
    BARRIER();
#undef BARRIER
#undef LOADT
#undef WRITET
}
#undef SBAR
}

constexpr int BATCH = 16, SEQ = 2048, DM = 2048, M = BATCH * SEQ, HD = 128;
constexpr int NQKV = 9216, WA = 1024, DFF = 5632, NFFN = 2 * DFF, NKV = 4096, NKVF = 4352;
constexpr int MODS_LD = 28672;
constexpr float EPS = 1e-6f;
constexpr int NWAVES = 8, NPHASE = 13;
#ifndef PROBE_DUP
#define PROBE_DUP 0
#endif
#ifndef MK_N_LAUNCHES
#define MK_N_LAUNCHES 1
#endif
constexpr size_t MiB = 1u << 20;
constexpr size_t WS_ROPE = 1 * MiB, WS_MODS = 2 * MiB, WS_LOGF = 4 * MiB, WS_FB = 6 * MiB, WS_LSE = 8 * MiB;
constexpr size_t WS_WQKV = 16 * MiB, WS_WOA = 52 * MiB, WS_WKV = 56 * MiB, WS_WQB = 73 * MiB, WS_WOB = 81 * MiB, WS_WFI = 89 * MiB, WS_WFO = 177 * MiB;
constexpr size_t WS_H = 224 * MiB, WS_BIG = 352 * MiB, WS_OCOMB = 928 * MiB, WS_END = 992 * MiB;
constexpr size_t WS_H2 = 704 * MiB, WS_QB = 832 * MiB, WS_KV = 352 * MiB;
constexpr size_t WS_XB = 704 * MiB;
constexpr size_t WS_SW = 11 * MiB, WS_RSS = 13 * MiB;
constexpr size_t SW_OFF0 = 0, SW_OFF1 = 16 * 11264, SW_OFF2 = SW_OFF1 + 16 * 4352, SW_OFF3 = SW_OFF2 + 16 * 2048;
constexpr int LDS_BYTES = 147456;

#define LAS __attribute__((address_space(3)))
typedef unsigned short bf16;
#define XB_TMO      128
#define XB_XCNT(j)  (256  + 64 * (j))
#define XB_XSUB(j)  (1280 + 64 * (j))
#define XB_XGEN(j)  (2304 + 64 * (j))
#define XB_TOP      3328
#define XB_TOPGEN   3392
#define XCD_BAR_WORDS 3456
#define XB_SPIN_CAP (1u << 18)

__device__ __forceinline__ unsigned xb_ld(unsigned* p)              { return __hip_atomic_load(p, __ATOMIC_RELAXED, __HIP_MEMORY_SCOPE_AGENT); }
__device__ __forceinline__ unsigned xb_add(unsigned* p, unsigned v) { return __hip_atomic_fetch_add(p, v, __ATOMIC_RELAXED, __HIP_MEMORY_SCOPE_AGENT); }
__device__ __forceinline__ unsigned xb_xcc_id() { return (unsigned)__builtin_amdgcn_s_getreg((3 << 11) | 20) & 0xFu; }
#define XB_SPIN(cond, bar) do { unsigned _sp = 0; while (cond) { __builtin_amdgcn_s_sleep(1); \
    if ((++_sp & 255u) == 0u) { if (xb_ld(&(bar)[XB_TMO])) break; if (_sp > XB_SPIN_CAP) { atomicAdd(&(bar)[XB_TMO], 1u); break; } } } } while (0)

struct XcdBarrier {
    unsigned* bar; unsigned x;
    volatile LAS unsigned* st;
};

__device__ __forceinline__ XcdBarrier xcd_barrier_post(unsigned* bar, volatile LAS unsigned* st) {
    XcdBarrier b; b.bar = bar; b.x = xb_xcc_id(); b.st = st;
    if (threadIdx.x == 0) (void)xb_add(&bar[XB_XCNT(b.x)], 1u);
    return b;
}
__device__ __forceinline__ void xcd_barrier_complete(unsigned* bar, unsigned x, unsigned& nloc, unsigned& nx) {
    const unsigned G = gridDim.x * gridDim.y * gridDim.z;
    unsigned sum, cnt, mine, sp = 0u;
    for (;;) {
        sum = 0u; cnt = 0u; mine = 0u;
#pragma unroll
        for (unsigned j = 0; j < 16; ++j) { const unsigned c = xb_ld(&bar[XB_XCNT(j)]); sum += c; cnt += (c > 0u) ? 1u : 0u; mine = (j == x) ? c : mine; }
        if (sum == G) break;
        __builtin_amdgcn_s_sleep(1);
        if ((++sp & 255u) == 0u) { if (xb_ld(&bar[XB_TMO])) break; if (sp > XB_SPIN_CAP) { atomicAdd(&bar[XB_TMO], 1u); break; } }
    }
    nloc = mine > 0u ? mine : 1u; nx = cnt > 0u ? cnt : 1u;
}

__device__ __forceinline__ void xcd_barrier(const XcdBarrier& b) {
    asm volatile("s_waitcnt vmcnt(0)" ::: "memory");
    __syncthreads();
    if (threadIdx.x == 0) {
        unsigned* bar = b.bar;
        __builtin_amdgcn_s_waitcnt(0);
        unsigned nloc = b.st[0], nx = b.st[1];
        if (nloc == 0u) { xcd_barrier_complete(bar, b.x, nloc, nx); b.st[0] = nloc; b.st[1] = nx; }
        const unsigned old = xb_add(&bar[XB_XSUB(b.x)], 1u);
        const unsigned gen = old / nloc;
        if (old + 1u == (gen + 1u) * nloc) {
            __builtin_amdgcn_fence(__ATOMIC_RELEASE, "agent");
            asm volatile("s_waitcnt vmcnt(0)" ::: "memory");
            const unsigned og = xb_add(&bar[XB_TOP], 1u);
            const unsigned tg = og / nx;
            if (og + 1u == (tg + 1u) * nx) xb_add(&bar[XB_TOPGEN], 1u);
            else XB_SPIN(xb_ld(&bar[XB_TOPGEN]) == tg, bar);
            __builtin_amdgcn_fence(__ATOMIC_ACQUIRE, "agent");
            xb_add(&bar[XB_XGEN(b.x)], 1u);
            asm volatile("s_waitcnt vmcnt(0)" ::: "memory");
        } else {
            XB_SPIN(xb_ld(&bar[XB_XGEN(b.x)]) == gen, bar);
            __builtin_amdgcn_fence(__ATOMIC_ACQUIRE, "agent");
            asm volatile("s_waitcnt vmcnt(0)" ::: "memory");
        }
    }
    __syncthreads();
}
typedef unsigned v4u __attribute__((ext_vector_type(4)));
typedef unsigned v2u __attribute__((ext_vector_type(2)));
typedef float f32x4 __attribute__((ext_vector_type(4)));
typedef float f32x2 __attribute__((ext_vector_type(2)));
__device__ __forceinline__ unsigned pk2(float lo, float hi) { unsigned r; asm volatile("v_cvt_pk_bf16_f32 %0, %1, %2" : "=v"(r) : "v"(lo), "v"(hi)); return r; }
__device__ __forceinline__ float bf_lo(unsigned w) { return __uint_as_float(w << 16); }
__device__ __forceinline__ float bf_hi(unsigned w) { return __uint_as_float(w & 0xffff0000u); }
__device__ __forceinline__ float wave_sum(float v) {
#pragma unroll
    for (int o = 1; o < 64; o <<= 1) v += __shfl_xor(v, o);
    return v;
}
struct Args { const float* in[21]; float* out; unsigned char* ws; int ph_lo, ph_hi; };
enum { I_X = 0, I_C, I_WADA, I_BADA, I_GNA, I_GNF, I_WQKVA, I_GQKA, I_WOA, I_WADAKV, I_BADAKV, I_GNKV, I_WKV, I_GKB, I_WF, I_BF, I_WQB, I_GQB, I_WOB, I_WFI, I_WFO };

constexpr int TSCR = 64 * 65 * 4;
__device__ __forceinline__ void transpose_item(const float* W, int K, int N, bf16* WT, int k0, int n0, int nd0, int kind, LAS float* scr, int lane) {
    const int lr = lane >> 4, lc = (lane & 15) * 4;
    f32x4 v[16];
    const float* wp = W + (size_t)(k0 + lr) * N + n0 + lc;
#pragma unroll
    for (int i = 0; i < 16; ++i) v[i] = *(const f32x4*)(wp + (size_t)(4 * i) * N);
#pragma unroll
    for (int i = 0; i < 16; ++i) { LAS float* d = scr + (4 * i + lr) * 65 + lc; d[0] = v[i].x; d[1] = v[i].y; d[2] = v[i].z; d[3] = v[i].w; }
    asm volatile("s_waitcnt lgkmcnt(0)" ::: "memory");
    const int c = lane & 7;
#pragma unroll
    for (int j = 0; j < 8; ++j) { const int n = (lane >> 3) + 8 * j; const LAS float* sp = scr + (8 * c) * 65 + n;
        v4u o; o.x = pk2(sp[0 * 65], sp[1 * 65]); o.y = pk2(sp[2 * 65], sp[3 * 65]); o.z = pk2(sp[4 * 65], sp[5 * 65]); o.w = pk2(sp[6 * 65], sp[7 * 65]);
        int nd = nd0 + n;
        if (kind == 2) { const int col = n0 + n, d = col & 127;
            if (col < 6144 && d < 32) nd = (col & ~31) + 8 * ((d & 15) >> 2) + 4 * (d >> 4) + (d & 3); }
        *(v4u*)(WT + (size_t)nd * K + k0 + 8 * c) = o; }
    asm volatile("s_waitcnt lgkmcnt(0)" ::: "memory");
}
__device__ __forceinline__ void transpose_matrix_items(const float* W, int K, int N, bf16* WT, int kind, int item, LAS float* scr, int lane) {
    const int nblk = N / 64, kb = item / nblk, nb = item % nblk, n0 = 64 * nb; int nd0 = n0;
    if (kind == 1) { const int half = n0 >= DFF, nn = n0 - half * DFF; nd0 = 256 * (nn >> 7) + 128 * half + (nn & 127); }
    transpose_item(W, K, N, WT, 64 * kb, n0, nd0, kind, scr, lane);
}
__device__ __forceinline__ void sincos_d(double a, double& s, double& c) {
    const double n = rint(a * 0.6366197723675814); const int q = (int)n & 3;
    double r = fma(-n, 1.5707963267948966, a); r = fma(-n, 6.123233995736766e-17, r);
    const double r2 = r * r;
    double sp = -7.647163731819816e-13; sp = fma(sp, r2, 1.6059043836821613e-10); sp = fma(sp, r2, -2.505210838544172e-08); sp = fma(sp, r2, 2.7557319223985893e-06);
    sp = fma(sp, r2, -1.984126984126984e-04); sp = fma(sp, r2, 8.333333333333333e-03); sp = fma(sp, r2, -1.6666666666666666e-01); sp = fma(sp * r2, r, r);
    double cp = 4.779477332387385e-14; cp = fma(cp, r2, -1.1470745597729725e-11); cp = fma(cp, r2, 2.08767569878681e-09); cp = fma(cp, r2, -2.755731922398589e-07);
    cp = fma(cp, r2, 2.48015873015873e-05); cp = fma(cp, r2, -1.388888888888889e-03); cp = fma(cp, r2, 4.1666666666666664e-02); cp = fma(cp, r2, -0.5); cp = fma(cp, r2, 1.0);
    s = (q == 0) ? sp : (q == 1) ? cp : (q == 2) ? -sp : -cp;
    c = (q == 0) ? cp : (q == 1) ? -sp : (q == 2) ? -cp : sp;
}
__device__ __forceinline__ float rope_inv(int i) {
    switch (i) { case 0: return 1.0f; case 1: return 0.44036659598350525f; case 2: return 0.1939227432012558f; case 3: return 0.08539710193872452f;
        case 4: return 0.03760603070259094f; case 5: return 0.01656043902039528f; case 6: return 0.007292664609849453f; case 7: return 0.0032114458736032248f;
        case 8: return 0.0014142135623842478f; case 9: return 0.000622772378847003f; case 10: return 0.00027424818836152554f; case 11: return 0.00012076973507646471f;
        case 12: return 5.318296098266728e-05f; case 13: return 2.34199997066753e-05f; case 14: return 1.0313386155758053e-05f; default: return 4.541670477919979e-06f; }
}
__device__ __forceinline__ void phase_prologue(const Args& a, LAS unsigned char* lds) {
    const int tid = threadIdx.x, lane = tid & 63, wave = __builtin_amdgcn_readfirstlane(tid >> 6), G = gridDim.x;
    unsigned char* ws = a.ws;
    for (int tk0 = blockIdx.x; tk0 < (MODS_LD / 128) * ((PROBE_DUP == 23) ? 1 + (a.ph_hi > 0) : 1); tk0 += G) { const int tk = tk0 % (MODS_LD / 128);
        LAS float* ct = (LAS float*)lds;
        for (int idx = tid; idx < BATCH * DM; idx += NWAVES * 64) { const int b = idx >> 11, k = idx & 2047; const float v = a.in[I_C][idx]; ct[k * 16 + b] = v / (1.f + __expf(-v)); }
        __syncthreads();
        const int col0 = tk * 128; const float* W; int pitch, wc0; const float* bias;
        if (col0 < 2 * 12288) { const int l = col0 / 12288; wc0 = col0 - l * 12288; W = a.in[I_WADA] + (size_t)l * DM * 12288; pitch = 12288; bias = a.in[I_BADA] + col0; }
        else { wc0 = col0 - 2 * 12288; W = a.in[I_WADAKV]; pitch = 4096; bias = a.in[I_BADAKV] + wc0; }
        float acc[16][2];
#pragma unroll
        for (int b = 0; b < 16; ++b) { acc[b][0] = 0.f; acc[b][1] = 0.f; }
        const float* wp = W + (size_t)(wave * 256) * pitch + wc0 + 2 * lane;
#pragma unroll 8
        for (int k = 0; k < 256; ++k) { const f32x2 wv = *(const f32x2*)(wp + (size_t)k * pitch); const LAS f32x4* cp = (const LAS f32x4*)(ct + (wave * 256 + k) * 16);
#pragma unroll
            for (int q = 0; q < 4; ++q) { const f32x4 cv = cp[q];
#pragma unroll
                for (int j = 0; j < 4; ++j) { acc[4 * q + j][0] = fmaf(cv[j], wv.x, acc[4 * q + j][0]); acc[4 * q + j][1] = fmaf(cv[j], wv.y, acc[4 * q + j][1]); } } }
        __syncthreads();
        LAS float* red = (LAS float*)lds;
#pragma unroll
        for (int b = 0; b < 16; ++b) { red[(wave * 16 + b) * 128 + 2 * lane] = acc[b][0]; red[(wave * 16 + b) * 128 + 2 * lane + 1] = acc[b][1]; }
        __syncthreads();
        float* mods = (float*)(ws + WS_MODS);
        for (int idx = tid; idx < 16 * 128; idx += NWAVES * 64) { const int b = idx >> 7, cc = idx & 127; float s = bias[cc];
#pragma unroll
            for (int w = 0; w < 8; ++w) s += red[(w * 16 + b) * 128 + cc];
            mods[(size_t)b * MODS_LD + col0 + cc] = s; }
        __syncthreads();
    }
    { float* rt = (float*)(ws + WS_ROPE);
      for (int idx = blockIdx.x * (NWAVES * 64) + tid; idx < SEQ * 16; idx += G * NWAVES * 64) { const int t = idx >> 4, i = idx & 15;
          const float ang = (float)t * rope_inv(i); double s, c; sincos_d((double)ang, s, c); rt[idx] = (float)c; rt[SEQ * 16 + idx] = (float)s; } }
    { bf16* wkv = (bf16*)(ws + WS_WKV) + (size_t)NKV * DM;
      for (int idx = blockIdx.x * (NWAVES * 64) + tid; idx < 256 * DM; idx += G * NWAVES * 64) { const int n = idx >> 11, k = idx & 2047;
          wkv[idx] = n < 16 ? (bf16)(pk2(a.in[I_WF][k * 16 + n], 0.f) & 0xffffu) : (bf16)0; } }
    { float* rss = (float*)(ws + WS_RSS); for (int idx = blockIdx.x * (NWAVES * 64) + tid; idx < 3 * M; idx += G * NWAVES * 64) rss[idx] = 0.f; }
    __syncthreads();
    LAS float* scr = (LAS float*)(lds + wave * TSCR);
    const int gw = blockIdx.x * NWAVES + wave, NGW = G * NWAVES;
    constexpr int I0 = (DM / 64) * (NQKV / 64), I1 = (WA / 64) * (DM / 64), I2 = (DM / 64) * (NKV / 64), I3 = (DM / 64) * (DM / 64), I5 = (DM / 64) * (NFFN / 64), I7 = (DFF / 64) * (DM / 64);
    constexpr int NIT = I0 + I1 + I2 + 2 * I3 + 2 * I5 + 2 * I7;
    for (int it = gw; it < NIT * ((PROBE_DUP == 24) ? 1 + (a.ph_hi > 0) : 1); it += NGW) {
        int r = it % NIT;
        if (r < I0) { transpose_matrix_items(a.in[I_WQKVA], DM, NQKV, (bf16*)(ws + WS_WQKV), 2, r, scr, lane); continue; } r -= I0;
        if (r < I1) { transpose_matrix_items(a.in[I_WOA], WA, DM, (bf16*)(ws + WS_WOA), 0, r, scr, lane); continue; } r -= I1;
        if (r < I2) { transpose_matrix_items(a.in[I_WKV], DM, NKV, (bf16*)(ws + WS_WKV), 0, r, scr, lane); continue; } r -= I2;
        if (r < I3) { transpose_matrix_items(a.in[I_WQB], DM, DM, (bf16*)(ws + WS_WQB), 0, r, scr, lane); continue; } r -= I3;
        if (r < I3) { transpose_matrix_items(a.in[I_WOB], DM, DM, (bf16*)(ws + WS_WOB), 0, r, scr, lane); continue; } r -= I3;
        if (r < 2 * I5) { const int l = r / I5; transpose_matrix_items(a.in[I_WFI] + (size_t)l * DM * NFFN, DM, NFFN, (bf16*)(ws + WS_WFI) + (size_t)l * NFFN * DM, 1, r - l * I5, scr, lane); continue; } r -= 2 * I5;
        { const int l = r / I7; transpose_matrix_items(a.in[I_WFO] + (size_t)l * DFF * DM, DFF, DM, (bf16*)(ws + WS_WFO) + (size_t)l * DM * DFF, 0, r - l * I7, scr, lane); }
    }
    __syncthreads();
}
template <bool DUAL>
__device__ __forceinline__ void phase_norm(const float* x, const float* g1, const float* sh1, const float* sc1, bf16* o1,
                                           const float* g2, const float* sh2, const float* sc2, bf16* o2) {
    const int lane = threadIdx.x & 63, wave = threadIdx.x >> 6; const int gw = blockIdx.x * NWAVES + wave, NGW = gridDim.x * NWAVES;
    f32x4 v[8];
    if (gw < M) { const f32x4* xr = (const f32x4*)(x + (size_t)gw * DM) + lane;
#pragma unroll
        for (int j = 0; j < 8; ++j) v[j] = xr[64 * j]; }
    for (int row = gw; row < M; row += NGW) {
        const int b = row >> 11; float s = 0.f;
        f32x4 nv[8]; const int nrow = row + NGW;
        if (nrow < M) { const f32x4* xr = (const f32x4*)(x + (size_t)nrow * DM) + lane;
#pragma unroll
            for (int j = 0; j < 8; ++j) nv[j] = xr[64 * j]; }
#pragma unroll
        for (int j = 0; j < 8; ++j) s += (v[j].x * v[j].x + v[j].y * v[j].y) + (v[j].z * v[j].z + v[j].w * v[j].w);
        const float rstd = 1.0f / sqrtf(wave_sum(s) * (1.f / DM) + EPS);
#pragma unroll
        for (int j = 0; j < 8; ++j) { const int col = 4 * lane + 256 * j;
            { const f32x4 gv = *(const f32x4*)(g1 + col), sh = *(const f32x4*)(sh1 + (size_t)b * MODS_LD + col), sc = *(const f32x4*)(sc1 + (size_t)b * MODS_LD + col);
              const f32x4 h = (v[j] * rstd * gv) * (sc + 1.f) + sh; v2u w; w.x = pk2(h.x, h.y); w.y = pk2(h.z, h.w); *(v2u*)(o1 + (size_t)row * DM + col) = w; }
            if (DUAL) { const f32x4 gv = *(const f32x4*)(g2 + col), sh = *(const f32x4*)(sh2 + (size_t)b * MODS_LD + col), sc = *(const f32x4*)(sc2 + (size_t)b * MODS_LD + col);
              const f32x4 h = (v[j] * rstd * gv) * (sc + 1.f) + sh; v2u w; w.x = pk2(h.x, h.y); w.y = pk2(h.z, h.w); *(v2u*)(o2 + (size_t)row * DM + col) = w; } }
#pragma unroll
        for (int j = 0; j < 8; ++j) v[j] = nv[j];
    }
}

__device__ __forceinline__ void phase_sw(const Args& a) {
    typedef short bf16x8_t __attribute__((ext_vector_type(8))); typedef float f32x16_t __attribute__((ext_vector_type(16)));
    const int lane = threadIdx.x & 63, wave = threadIdx.x >> 6; const int gw = blockIdx.x * NWAVES + wave, NGW = gridDim.x * NWAVES;
    unsigned char* ws = a.ws; const float* mods = (const float*)(ws + WS_MODS); float* SW = (float*)(ws + WS_SW);
    constexpr int T0 = NFFN / 32, T1 = NKVF / 32, T2 = DM / 32, NT = 2 * T0 + T1 + T2;
    const int m = lane & 31, kh = lane >> 5;
    for (int t = gw; t < NT; t += NGW) {
        const bf16* Bt; const float* sh; float* out; int nrows, r0;
        if (t < T0) { Bt = (const bf16*)(ws + WS_WFI); sh = mods + 6144; out = SW + SW_OFF0; nrows = NFFN; r0 = t * 32; }
        else if (t < T0 + T1) { Bt = (const bf16*)(ws + WS_WKV); sh = mods + 24576; out = SW + SW_OFF1; nrows = NKVF; r0 = (t - T0) * 32; }
        else if (t < T0 + T1 + T2) { Bt = (const bf16*)(ws + WS_WQB); sh = mods + 12288; out = SW + SW_OFF2; nrows = DM; r0 = (t - T0 - T1) * 32; }
        else { Bt = (const bf16*)(ws + WS_WFI) + (size_t)NFFN * DM; sh = mods + 12288 + 6144; out = SW + SW_OFF3; nrows = NFFN; r0 = (t - T0 - T1 - T2) * 32; }
        const bf16* ap = Bt + (size_t)(r0 + m) * DM + kh * 8; const float* bp = sh + (size_t)(m & 15) * MODS_LD + kh * 8;
        f32x16_t acc = {};
#pragma unroll 8
        for (int kk = 0; kk < DM / 16; ++kk) { const bf16x8_t av = *(const bf16x8_t*)(ap + kk * 16);
            const f32x4 b0 = *(const f32x4*)(bp + kk * 16), b1 = *(const f32x4*)(bp + kk * 16 + 4);
            v4u w; w.x = pk2(b0.x, b0.y); w.y = pk2(b0.z, b0.w); w.z = pk2(b1.x, b1.y); w.w = pk2(b1.z, b1.w);
            if (m >= 16) { w.x = 0; w.y = 0; w.z = 0; w.w = 0; }
            acc = __builtin_amdgcn_mfma_f32_32x32x16_bf16(av, __builtin_bit_cast(bf16x8_t, w), acc, 0, 0, 0); }
        if (m < 16) {
#pragma unroll
            for (int r = 0; r < 16; ++r) out[(size_t)m * nrows + r0 + (r & 3) + 8 * (r >> 2) + 4 * kh] = acc[r]; }
    }
}

__device__ __forceinline__ void phase_fgate(const bf16* Hm, const bf16* Wf, const float* rss, const float* swf, float* logf) {
    typedef short bf16x8_t __attribute__((ext_vector_type(8))); typedef float f32x16_t __attribute__((ext_vector_type(16)));
    const int lane = threadIdx.x & 63, wave = threadIdx.x >> 6; const int gw = blockIdx.x * NWAVES + wave, NGW = gridDim.x * NWAVES;
    const int m = lane & 31, kh = lane >> 5;
    for (int t = gw; t < M / 32; t += NGW) {
        const int r0 = t * 32;
        const bf16* ap = Hm + (size_t)(r0 + m) * DM + kh * 8; const bf16* bp = Wf + (size_t)m * DM + kh * 8;
        f32x16_t acc = {};
#pragma unroll 8
        for (int kk = 0; kk < DM / 16; ++kk) acc = __builtin_amdgcn_mfma_f32_32x32x16_bf16(*(const bf16x8_t*)(ap + kk * 16), *(const bf16x8_t*)(bp + kk * 16), acc, 0, 0, 0);
        if (m < 16) { const int b = r0 >> 11; const float sv = swf[(size_t)b * NKVF + NKV + m]; float* op = logf + ((size_t)b * 16 + m) * SEQ + (r0 & (SEQ - 1));
#pragma unroll
            for (int r = 0; r < 16; ++r) { const int rr = (r & 3) + 8 * (r >> 2) + 4 * kh; op[rr] = acc[r] * __builtin_amdgcn_rsqf(rss[r0 + rr] * (1.f / DM) + EPS) + sv; } }
    }
}
template <bool ROPE>
__device__ __forceinline__ void phase_qknorm(bf16* buf, size_t pitch, int nchunk, const float* gains, int gshift, const float* rope, int dry = 0) {
    const int lane = threadIdx.x & 63, wave = threadIdx.x >> 6; const int gw = blockIdx.x * NWAVES + wave, NGW = gridDim.x * NWAVES;
    const int nq = nchunk >> 2, j = lane & 15; const long total = (long)M * nq;
    for (long it0 = gw; it0 < total; it0 += 4L * NGW) {
        v4u raw[4]; bf16* pp[4]; int ch[4], tok[4]; bool ok[4];
#pragma unroll
        for (int u = 0; u < 4; ++u) { const long it = it0 + (long)u * NGW; ok[u] = it < total; const long itc = ok[u] ? it : it0; tok[u] = (int)(itc / nq); ch[u] = (int)(itc % nq) * 4 + (lane >> 4);
            pp[u] = buf + (size_t)tok[u] * pitch + ch[u] * 128 + j * 8; raw[u] = *(const v4u*)pp[u]; }
#pragma unroll
        for (int u = 0; u < 4; ++u) {
            float x[8]; x[0] = bf_lo(raw[u].x); x[1] = bf_hi(raw[u].x); x[2] = bf_lo(raw[u].y); x[3] = bf_hi(raw[u].y); x[4] = bf_lo(raw[u].z); x[5] = bf_hi(raw[u].z); x[6] = bf_lo(raw[u].w); x[7] = bf_hi(raw[u].w);
            float ss = 0.f;
#pragma unroll
            for (int i = 0; i < 8; ++i) ss += x[i] * x[i];
            ss += __shfl_xor(ss, 1); ss += __shfl_xor(ss, 2); ss += __shfl_xor(ss, 4); ss += __shfl_xor(ss, 8);
            const float rstd = 1.0f / sqrtf(ss * (1.f / HD) + EPS);
            const float* gp = gains + (size_t)(ch[u] >> gshift) * HD + j * 8; const f32x4 g0 = *(const f32x4*)gp, g1 = *(const f32x4*)(gp + 4);
            float y[8];
#pragma unroll
            for (int i = 0; i < 4; ++i) { y[i] = x[i] * rstd * g0[i]; y[4 + i] = x[4 + i] * rstd * g1[i]; }
            if (ROPE) { const int pos = tok[u] & (SEQ - 1); const float* cp = rope + pos * 16 + (j & 1) * 8; const float* sp = cp + SEQ * 16;
#pragma unroll
                for (int i = 0; i < 8; ++i) { const float pv = __shfl_xor(y[i], 2); const float c = cp[i], s = sp[i];
                    const float r = (j < 2) ? (y[i] * c - pv * s) : (y[i] * c + pv * s); y[i] = (j < 4) ? r : y[i]; } }
            v4u w; w.x = pk2(y[0], y[1]); w.y = pk2(y[2], y[3]); w.z = pk2(y[4], y[5]); w.w = pk2(y[6], y[7]);
            if (ok[u] && !dry) *(v4u*)pp[u] = w;
        }
    }
}
__device__ __forceinline__ void phase_combine(const bf16* qkv, const float* lse, bf16* oc) {
    const int lane = threadIdx.x & 63, wave = threadIdx.x >> 6; const int gw = blockIdx.x * NWAVES + wave, NGW = gridDim.x * NWAVES;
    const int j = lane & 15; const long total = (long)M * 2;
    constexpr int UN = 4;
    for (long it0 = gw; it0 < total; it0 += (long)UN * NGW) {
        v4u raw[UN][3]; float l[UN][3]; int tok[UN], h[UN]; bool ok[UN];
#pragma unroll
        for (int u = 0; u < UN; ++u) { const long it = it0 + (long)u * NGW; ok[u] = it < total; const long itc = ok[u] ? it : it0; tok[u] = (int)(itc >> 1); h[u] = (int)(itc & 1) * 4 + (lane >> 4);
#pragma unroll
            for (int g = 0; g < 3; ++g) { raw[u][g] = *(const v4u*)(qkv + (size_t)tok[u] * NQKV + g * WA + h[u] * HD + j * 8); l[u][g] = lse[((size_t)g * M + tok[u]) * 8 + h[u]]; } }
#pragma unroll
        for (int u = 0; u < UN; ++u) {
            const float mx = fmaxf(l[u][0], fmaxf(l[u][1], l[u][2])); float e[3]; e[0] = __expf(l[u][0] - mx); e[1] = __expf(l[u][1] - mx); e[2] = __expf(l[u][2] - mx);
            const float inv = 1.f / (e[0] + e[1] + e[2]); float y[8];
#pragma unroll
            for (int i = 0; i < 8; ++i) y[i] = 0.f;
#pragma unroll
            for (int g = 0; g < 3; ++g) { const float al = e[g] * inv; const v4u r = raw[u][g];
                y[0] += al * bf_lo(r.x); y[1] += al * bf_hi(r.x); y[2] += al * bf_lo(r.y); y[3] += al * bf_hi(r.y);
                y[4] += al * bf_lo(r.z); y[5] += al * bf_hi(r.z); y[6] += al * bf_lo(r.w); y[7] += al * bf_hi(r.w); }
            v4u w; w.x = pk2(y[0], y[1]); w.y = pk2(y[2], y[3]); w.z = pk2(y[4], y[5]); w.w = pk2(y[6], y[7]);
            if (ok[u]) *(v4u*)(oc + (size_t)tok[u] * WA + h[u] * HD + j * 8) = w;
        }
    }
}
__device__ __forceinline__ void phase_scan(const float* logf, float* fb) {
    const int lane = threadIdx.x & 63, wave = threadIdx.x >> 6;
    if (wave != 0) return;
    for (int bh = blockIdx.x; bh < BATCH * 16; bh += gridDim.x) {
        const int b = bh >> 4, h = bh & 15; const float* p = logf + ((size_t)b * SEQ + lane * 32) * 16 + h;
        double tot = 0.0;
        for (int i = 0; i < 32; ++i) tot += (double)p[i * 16];
        double incl = tot;
#pragma unroll
        for (int o = 1; o < 64; o <<= 1) { const double t = __shfl_up(incl, o); if (lane >= o) incl += t; }
        double run = incl - tot;
        for (int i = 0; i < 32; ++i) { run += (double)p[i * 16]; fb[(size_t)bh * SEQ + lane * 32 + i] = (float)(-run * 11.313708498984761); }
    }
}
__device__ __forceinline__ void phase_attn_a(bf16* qkv, float* lse, LAS unsigned char* lds, int dry) {
    const int wid = __builtin_amdgcn_readfirstlane(threadIdx.x >> 6), half = wid >> 2;
    constexpr int NU = BATCH * 3 * 4 * 16;
    const int G_ = gridDim.x, bx_ = blockIdx.x; const int vcu_ = (G_ % 8 == 0) ? (bx_ % 8) * (G_ / 8) + bx_ / 8 : bx_;
    for (int u = vcu_; u < NU; u += G_) {
        const int g = u >> 10, rem = u & 1023, bhp = rem >> 4, idx = rem & 15, b = bhp >> 2, h = (bhp & 3) * 2 + half;
        int dil, res, qb;
        if (g == 0) { dil = 1; res = 0; qb = idx; } else if (g == 1) { dil = 4; res = idx & 3; qb = idx >> 2; } else { dil = 16; res = idx; qb = 0; }
        const size_t tok0 = (size_t)b * SEQ + res;
        att::Unit U;
        const bf16* base = qkv + tok0 * NQKV + h * HD;
        U.ldq = (long)NQKV * dil; U.ldk = U.ldq;
        U.Q = base + (size_t)g * WA + (size_t)(qb * 128) * U.ldq; U.O = (bf16*)U.Q;
        U.K = base + (size_t)(3 + g) * WA; U.V = base + (size_t)(6 + g) * WA;
        U.P0 = qb * 128; U.W = 129; U.j_lo = qb ? 2 * qb - 2 : 0; U.NT = qb ? 4 : 2;
        U.lse = lse + ((size_t)g * M + tok0 + (size_t)(qb * 128) * dil) * 8 + h; U.lse_ld = 8L * dil; U.dry = dry;
        att::attn_unit<false, false>(U, (ALAS char*)lds);
    }
}
__device__ __forceinline__ void phase_attn_b(bf16* qb_, const bf16* kv, const float* logf, const float* bfp, LAS unsigned char* lds, int dry) {
    const int G = gridDim.x, bx = blockIdx.x; const int vcu = (G % 8 == 0) ? (bx % 8) * (G / 8) + bx / 8 : bx;
    constexpr int NU = BATCH * 16 * 8;
    for (int u = (G == 256 ? 0 : bx); u < (G == 256 ? 8 : NU); u += (G == 256 ? 1 : G)) {
        int bh, qblk;
        if (G == 256) { const int j = vcu & 7, p = j & 3; bh = (vcu >> 3) * 8 + 2 * (u >> 1) + (j >> 2); qblk = (u & 1) ? 7 - p : p; }
        else { bh = u >> 3; qblk = u & 7; }
        const int b = bh >> 4, h = bh & 15;
        att::Unit U;
        U.ldq = DM; U.ldk = NKV;
        U.Q = qb_ + ((size_t)b * SEQ + qblk * 256) * DM + h * HD; U.O = (bf16*)U.Q;
        U.K = kv + (size_t)b * SEQ * NKV + h * HD; U.V = U.K + DM;
        U.P0 = qblk * 256; U.W = 1 << 30; U.j_lo = 0; U.NT = 4 * (qblk + 1);
        U.lse = nullptr; U.lse_ld = 0; U.dry = dry;
        { int tid = threadIdx.x; asm volatile("" : "+v"(tid));
          const int lane = tid & 63, wave = tid >> 6;
          const f32x4 zr = *(const f32x4*)(logf + (size_t)bh * SEQ + 4 * tid); const float bfv = bfp[h];
          float zv[4];
#pragma unroll
          for (int i = 0; i < 4; ++i) { const float z = zr[i] + bfv; zv[i] = fminf(z, 0.f) - __logf(1.f + __expf(-fabsf(z))); }
          const double s1 = (double)zv[0], s2 = s1 + (double)zv[1], s3 = s2 + (double)zv[2], s4 = s3 + (double)zv[3];
          double incl = s4;
#pragma unroll
          for (int o = 1; o < 64; o <<= 1) { const double t = __shfl_up(incl, o); if (lane >= o) incl += t; }
          LAS double* wt = (LAS double*)(lds + att::SCR_OFF);
          if (lane == 63) wt[wave] = incl;
          __syncthreads();
          double off = incl - s4;
          for (int w = 0; w < wave; ++w) off += wt[w];
          LAS float* fbl = (LAS float*)(lds + att::FB_OFF) + 4 * tid; const double c = -11.313708498984761;
          fbl[0] = (float)((off + s1) * c); fbl[1] = (float)((off + s2) * c); fbl[2] = (float)((off + s3) * c); fbl[3] = (float)((off + s4) * c);
          __syncthreads(); }
        att::attn_unit_pipe<true>(U, (ALAS char*)lds);
    }
}

using EpiQKV = pg8::EpiStore<true, false>; using EpiKVQ = pg8::EpiStore<false, true>;
using EpiR5 = pg8::EpiResid<1, false, true>; using EpiR7 = pg8::EpiResid<2, true, true>; using EpiR10 = pg8::EpiResid<1, true, true>; using EpiR12 = pg8::EpiResid<0, true, false>;
__global__ void __launch_bounds__(NWAVES * 64) yoco_fwd(Args a) {
    extern __shared__ __attribute__((aligned(16))) unsigned char lds_raw[];
    LAS unsigned char* lds = (LAS unsigned char*)lds_raw;
    cg::grid_group grid = cg::this_grid();
    volatile LAS unsigned* MISC = (volatile LAS unsigned*)(lds + LDS_BYTES - 64);
    if (threadIdx.x < 16) MISC[threadIdx.x] = 0u;
    __syncthreads();
    XcdBarrier xbar = xcd_barrier_post((unsigned*)a.ws, MISC + 8);
    if (a.ph_hi < 0) grid.sync();
    unsigned char* ws = a.ws; const int G = gridDim.x, bx = blockIdx.x;
    const int lo = a.ph_lo, hi = a.ph_hi;
    float* mods = (float*)(ws + WS_MODS); float* xo = a.out;
    bf16* H = (bf16*)(ws + WS_H); bf16* H2 = (bf16*)((unsigned char*)a.out + 128 * MiB); bf16* QKV = (bf16*)(ws + WS_BIG); bf16* ACT = (bf16*)(ws + WS_BIG);
    bf16* OC = (bf16*)a.out; bf16* QB = (bf16*)(ws + WS_QB); bf16* KV = (bf16*)(ws + WS_KV);
    bf16* XB = (bf16*)(ws + WS_XB);
    float* LSE = (float*)(ws + WS_LSE); float* LOGF = (float*)(ws + WS_LOGF); float* FB = (float*)(ws + WS_FB); const float* ROPE = (const float*)(ws + WS_ROPE);
#define IN(k) (lo <= (k) && (k) < hi)
#define SEAM(k) do { if (IN(k) && IN((k) + 1)) xcd_barrier(xbar); } while (0)
#define GEMM(EPI, Aptr, Bptr, N_, K_, E) GEMMR(EPI, Aptr, Bptr, N_, K_, E, 1)
#define GEMMR(EPI, Aptr, Bptr, N_, K_, E, R_) do { pg8::Gemm g_{(const pg8::bf16_t*)(Aptr), (const pg8::bf16_t*)(Bptr), M, (N_), (K_)}; pg8::StaticOrder S_; S_.init(M, (N_), G, bx); S_.rep = (R_); \
        pg8::gemm_phase<EPI, pg8::StaticOrder, true, true>(lds, g_, S_, E); } while (0)
#define NREP(k) ((PROBE_DUP == (k)) ? 1 + (a.ph_hi > 0) : 1)
    float* RSS = (float*)(ws + WS_RSS); const float* SW = (const float*)(ws + WS_SW);
    if (IN(0)) { phase_prologue(a, lds); } SEAM(0);
    if (IN(1)) { phase_norm<false>(a.in[I_X], a.in[I_GNA], mods + 0, mods + 2048, H, nullptr, nullptr, nullptr, nullptr); phase_sw(a); } SEAM(1);
    if (IN(2)) { EpiQKV E{QKV, NQKV, 1 << 30, nullptr, nullptr, 24, a.in[I_GQKA], 3, ROPE, nullptr, nullptr, 0}; GEMMR(EpiQKV, H, ws + WS_WQKV, NQKV, DM, E, NREP(30)); } SEAM(2);
    if (IN(3)) {
_Pragma("nounroll")
        for (int rep = 0; rep < NREP(40); ++rep) phase_attn_a(QKV, LSE, lds, rep + 1 < NREP(40)); } SEAM(3);
    if (IN(4)) { phase_combine(QKV, LSE, OC); } SEAM(4);
    if (IN(5)) { EpiR5 E{a.in[I_X], XB, DM, mods + 4096, MODS_LD, RSS, a.in[I_GNF], mods + 8192, H, nullptr, nullptr, nullptr}; GEMMR(EpiR5, OC, ws + WS_WOA, DM, WA, E, NREP(33)); } SEAM(5);
    if (IN(6)) { pg8::EpiSwiglu E{ACT, DFF, RSS, SW + SW_OFF0, NFFN}; GEMMR(pg8::EpiSwiglu, H, ws + WS_WFI, NFFN, DM, E, NREP(8)); } SEAM(6);
    if (IN(7)) { EpiR7 E{XB, XB, DM, mods + 10240, MODS_LD, RSS + M, a.in[I_GNKV], mods + 24576 + 2048, H, a.in[I_GNA] + DM, mods + 12288 + 2048, H2}; GEMMR(EpiR7, ACT, ws + WS_WFO, DM, DFF, E, NREP(31)); } SEAM(7);
    if (IN(8)) { { EpiKVQ E{KV, NKV, 1 << 30, nullptr, nullptr, 8, a.in[I_GKB], 31, nullptr, RSS + M, SW + SW_OFF1, NKVF}; GEMMR(EpiKVQ, H, ws + WS_WKV, NKV, DM, E, NREP(32)); }
                 { EpiKVQ E{QB, DM, 1 << 30, nullptr, nullptr, 8, a.in[I_GQB], 31, nullptr, RSS + M, SW + SW_OFF2, DM}; GEMMR(EpiKVQ, H2, ws + WS_WQB, DM, DM, E, NREP(32)); }
                 phase_fgate(H, (const bf16*)(ws + WS_WKV) + (size_t)NKV * DM, RSS + M, SW + SW_OFF1, LOGF); } SEAM(8);
    if (IN(9)) {
_Pragma("nounroll")
        for (int rep = 0; rep < NREP(41); ++rep) phase_attn_b(QB, KV, LOGF, a.in[I_BF], lds, rep + 1 < NREP(41)); } SEAM(9);
    if (IN(10)) { EpiR10 E{XB, XB, DM, mods + 12288 + 4096, MODS_LD, RSS + 2 * M, a.in[I_GNF] + DM, mods + 12288 + 8192, H, nullptr, nullptr, nullptr}; GEMMR(EpiR10, QB, ws + WS_WOB, DM, DM, E, NREP(33)); } SEAM(10);
    if (IN(11)) { pg8::EpiSwiglu E{ACT, DFF, RSS + 2 * M, SW + SW_OFF3, NFFN}; GEMM(pg8::EpiSwiglu, H, (bf16*)(ws + WS_WFI) + (size_t)NFFN * DM, NFFN, DM, E); } SEAM(11);
    if (IN(12)) { EpiR12 E{XB, xo, DM, mods + 12288 + 10240, MODS_LD, nullptr, nullptr, nullptr, nullptr, nullptr, nullptr, nullptr}; GEMMR(EpiR12, ACT, (bf16*)(ws + WS_WFO) + (size_t)DM * DFF, DM, DFF, E, NREP(31)); }
#undef IN
#undef SEAM
#undef GEMM
#undef GEMMR
}

extern "C" void kernel_launch(void* const* d_in, const int* in_sizes, int n_in, void* d_out, int out_size, void* d_ws, size_t ws_size, hipStream_t stream) {
    static int grid = 0;
    if (grid == 0) {
        if (n_in != 21 || in_sizes[0] != M * DM || out_size != M * DM || ws_size < WS_END) { fprintf(stderr, "kernel_launch: unexpected shapes (n_in %d, in0 %d, out %d, ws %zu)\n", n_in, n_in > 0 ? in_sizes[0] : -1, out_size, ws_size); grid = -1; return; }
        int dev = 0, cus = 0, per_cu = 0;
        (void)hipGetDevice(&dev); (void)hipDeviceGetAttribute(&cus, hipDeviceAttributeMultiprocessorCount, dev);
        if (hipFuncSetAttribute((const void*)yoco_fwd, hipFuncAttributeMaxDynamicSharedMemorySize, LDS_BYTES) != hipSuccess) { fprintf(stderr, "kernel_launch: hipFuncSetAttribute failed\n"); grid = -1; return; }
        if (hipOccupancyMaxActiveBlocksPerMultiprocessor(&per_cu, (const void*)yoco_fwd, NWAVES * 64, LDS_BYTES) != hipSuccess || per_cu < 1) { fprintf(stderr, "kernel_launch: occupancy query says %d\n", per_cu); per_cu = 1; }
        (void)hipGetLastError();
        grid = cus > 0 ? cus : 256;
    }
    if (grid < 0) return;
    if (hipMemsetAsync(d_ws, 0, 16384, stream) != hipSuccess) { fprintf(stderr, "kernel_launch: memset failed\n"); return; }
    Args a{};
    for (int i = 0; i < 21; ++i) a.in[i] = (const float*)d_in[i];
    a.out = (float*)d_out; a.ws = (unsigned char*)d_ws;
#if MK_N_LAUNCHES == 1
    a.ph_lo = 0; a.ph_hi = NPHASE;
    void* args[] = {&a};
    hipError_t e = hipLaunchCooperativeKernel((const void*)yoco_fwd, dim3(grid), dim3(NWAVES * 64), args, LDS_BYTES, stream);
    if (e != hipSuccess) fprintf(stderr, "kernel_launch: cooperative launch failed: %s (grid %d)\n", hipGetErrorString(e), grid);
#else
    for (int p = 0; p < NPHASE; ++p) { a.ph_lo = p; a.ph_hi = p + 1; hipLaunchKernelGGL(yoco_fwd, dim3(grid), dim3(NWAVES * 64), LDS_BYTES, stream, a); }
#endif
}
```

```cpp
#include <hip/hip_runtime.h>
#include <hip/hip_cooperative_groups.h>
#include <cstdio>
#include <cstdint>
namespace cg = cooperative_groups;
namespace pg8 {
#define PG8_LAS __attribute__((address_space(3)))
typedef unsigned short bf16_t;
typedef short bf16x8 __attribute__((ext_vector_type(8)));
typedef float f32x4 __attribute__((ext_vector_type(4)));
typedef unsigned u32x4 __attribute__((ext_vector_type(4)));
constexpr int BM = 256, BK = 64, HALF = 128, HTB = HALF * BK * 2  , STAGE_BYTES = 8 * HTB, NXCD = 8, WGM = 4;

__host__ __device__ __forceinline__ int lds_byte(int r, int c) { const int st = (r >> 4) * 2 + (c >> 5), rr = r & 15, cc = c & 31, ob = rr * 64 + cc * 2; return st * 1024 + (ob ^ (((ob >> 9) & 1) << 5)); }
__host__ __device__ __forceinline__ void stage_rc(int b, int& R, int& C) { const int st = b / 1024, sb = b % 1024, swz = sb ^ (((sb >> 9) & 1) << 5); R = (st >> 1) * 16 + swz / 64; C = (st & 1) * 32 + (swz % 64) / 2; }
__host__ __device__ __forceinline__ int perm32(int rho) { const int n = rho >> 4, i = rho & 15; return 8 * (i >> 2) + 4 * n + (i & 3); }

struct Unit { int pm, pn, dry; };
struct Gemm { const bf16_t* A; const bf16_t* Bt; int M, N, K; };

struct StaticOrder {
    int nM, nN, nwg, G, c, rep;
    __host__ __device__ void init(int M, int N, int G_, int c_) { nM = M / BM; nN = N / BM; nwg = nM * nN; G = G_; c = c_; rep = 1; }
    __host__ __device__ bool next(int i, Unit& u) const {
        long L = (long)i * G + c; if (L >= (long)nwg * rep) return false; u.dry = 0; if (L >= nwg) { L -= nwg; u.dry = 1; }
        int wgid = (int)L; { const int q = nwg / NXCD, r = nwg % NXCD, xcd = wgid % NXCD, off = wgid / NXCD; wgid = (xcd < r ? xcd * (q + 1) : r * (q + 1) + (xcd - r) * q) + off; }
        const int nig = WGM * nN, gid = wgid / nig, fm = gid * WGM, gsz = (nM - fm) < WGM ? (nM - fm) : WGM;
        u.pm = fm + ((wgid % nig) % gsz); u.pn = (wgid % nig) / gsz; return true;
    }
    __device__ __forceinline__ void a_ready(const Unit&) const {}
    __device__ __forceinline__ void done(const Unit&) const {}
};

__device__ __forceinline__ unsigned cvt_pk_bf16(float lo, float hi) { unsigned r; asm volatile("v_cvt_pk_bf16_f32 %0, %1, %2" : "=v"(r) : "v"(lo), "v"(hi)); return r; }
template <bool ROPE, bool FUSED>
struct EpiStore {
    static constexpr bool PERM = true, AFTER_DRAIN = false;
    bf16_t* O; int ldc; int ftile; float* logf; const float* bf; int norm_tiles; const float* gains; int gsh; const float* rope; const float* rowss; const float* sw; int swpitch;
    __device__ __forceinline__ void operator()(const f32x4 (&acc_in)[2][2][4][2], const Unit& u, int wr, int wc, int fr_in, int fq_in, PG8_LAS unsigned char* lds) const {
        int fr = fr_in, fq = fq_in; asm volatile("" : "+v"(fr), "+v"(fq));
        const int row0 = u.pm * BM + wr * 64 + fr;
        float rstd[2][4]; f32x4 sv[2][2];
        if constexpr (FUSED) { const float* sp = sw + (size_t)(u.pm >> 3) * swpitch + u.pn * BM + wc * 32 + 8 * fq;
#pragma unroll
            for (int bj = 0; bj < 2; ++bj)
#pragma unroll
                for (int n = 0; n < 2; ++n) sv[bj][n] = *(const f32x4*)(sp + bj * HALF + 4 * n);
#pragma unroll
            for (int ai = 0; ai < 2; ++ai)
#pragma unroll
                for (int m = 0; m < 4; ++m) rstd[ai][m] = __builtin_amdgcn_rsqf(rowss[row0 + ai * HALF + m * 16] * (1.f / 2048.f) + 1e-6f);
        } else {
#pragma unroll
            for (int bj = 0; bj < 2; ++bj)
#pragma unroll
                for (int n = 0; n < 2; ++n) sv[bj][n] = (f32x4){0.f, 0.f, 0.f, 0.f};
#pragma unroll
            for (int ai = 0; ai < 2; ++ai)
#pragma unroll
                for (int m = 0; m < 4; ++m) rstd[ai][m] = 1.f;
        }
#define ACCV(ai, bj, m, n) (FUSED ? (acc_in[ai][bj][m][n] * rstd[ai][m] + sv[bj][n]) : acc_in[ai][bj][m][n])
        if (FUSED && u.pn >= ftile) {
            if (wc == 0 && fq < 2) {
#pragma unroll
                for (int ai = 0; ai < 2; ++ai)
#pragma unroll
                    for (int m = 0; m < 4; ++m) { const int row = row0 + ai * HALF + m * 16; float* rp = logf + ((size_t)(row >> 11) * 16 + 8 * fq) * 2048 + (row & 2047);
#pragma unroll
                        for (int n = 0; n < 2; ++n) { const f32x4 z = ACCV(ai, 0, m, n);
#pragma unroll
                            for (int j = 0; j < 4; ++j) rp[(size_t)(4 * n + j) * 2048] = z[j]; } }
            }
            return;
        }
        const bool nrm = u.pn < norm_tiles;
        float rs[2][4][2]; f32x4 gv[2][2];
        if (nrm) {
            PG8_LAS float* P = (PG8_LAS float*)(lds + STAGE_BYTES);
#pragma unroll
            for (int ai = 0; ai < 2; ++ai)
#pragma unroll
                for (int m = 0; m < 4; ++m)
#pragma unroll
                    for (int bj = 0; bj < 2; ++bj) { const f32x4 x0 = ACCV(ai, bj, m, 0), x1 = ACCV(ai, bj, m, 1);
                        float q = (x0[0] * x0[0] + x0[1] * x0[1]) + (x0[2] * x0[2] + x0[3] * x0[3]) + (x1[0] * x1[0] + x1[1] * x1[1]) + (x1[2] * x1[2] + x1[3] * x1[3]);
                        q += __shfl_xor(q, 16); q += __shfl_xor(q, 32);
                        if (fq == 0) P[((ai * HALF + wr * 64 + m * 16 + fr) * 2 + bj) * 4 + wc] = q; }
            asm volatile("s_waitcnt lgkmcnt(0)\n\ts_barrier" ::: "memory");
#pragma unroll
            for (int ai = 0; ai < 2; ++ai)
#pragma unroll
                for (int m = 0; m < 4; ++m)
#pragma unroll
                    for (int bj = 0; bj < 2; ++bj) { const f32x4 p = *(const PG8_LAS f32x4*)(P + ((ai * HALF + wr * 64 + m * 16 + fr) * 2 + bj) * 4);
                        rs[ai][m][bj] = __builtin_amdgcn_rsqf(((p[0] + p[1]) + (p[2] + p[3])) * (1.f / 128.f) + 1e-6f); }
#pragma unroll
            for (int bj = 0; bj < 2; ++bj) { const float* gp = gains + (size_t)((2 * u.pn + bj) >> gsh) * 128;
                if (ROPE && wc == 0) { gv[bj][0] = *(const f32x4*)(gp + 4 * fq); gv[bj][1] = *(const f32x4*)(gp + 4 * fq + 16); }
                else { gv[bj][0] = *(const f32x4*)(gp + wc * 32 + 8 * fq); gv[bj][1] = *(const f32x4*)(gp + wc * 32 + 8 * fq + 4); } }
        }
        const bool rp_on = ROPE && nrm && wc == 0;
        const int col0 = u.pn * BM + wc * 32 + 8 * fq;
#pragma unroll
        for (int ai = 0; ai < 2; ++ai) {
            f32x4 cs[4][2];
            if (rp_on) {
#pragma unroll
                for (int m = 0; m < 4; ++m) { const float* cp = rope + (size_t)((row0 + ai * HALF + m * 16) & 2047) * 16 + 4 * fq; cs[m][0] = *(const f32x4*)cp; cs[m][1] = *(const f32x4*)(cp + 2048 * 16); }
                asm volatile("" ::: "memory"); }
#pragma unroll
            for (int m = 0; m < 4; ++m) { const int row = row0 + ai * HALF + m * 16; bf16_t* rowp = O + (size_t)row * ldc + col0;
#pragma unroll
                for (int bj = 0; bj < 2; ++bj) { f32x4 v0 = ACCV(ai, bj, m, 0), v1 = ACCV(ai, bj, m, 1);
                    if (nrm) { v0 = v0 * rs[ai][m][bj] * gv[bj][0]; v1 = v1 * rs[ai][m][bj] * gv[bj][1]; }
                    if (rp_on) { const f32x4 x1 = v0, x2 = v1; v0 = x1 * cs[m][0] - x2 * cs[m][1]; v1 = x2 * cs[m][0] + x1 * cs[m][1]; }
                    u32x4 w; w.x = cvt_pk_bf16(v0[0], v0[1]); w.y = cvt_pk_bf16(v0[2], v0[3]); w.z = cvt_pk_bf16(v1[0], v1[1]); w.w = cvt_pk_bf16(v1[2], v1[3]);
                    *(u32x4*)(rowp + bj * HALF) = w; } }
        }
    }
#undef ACCV
};
struct EpiSwiglu {
    static constexpr bool PERM = true, AFTER_DRAIN = false;
    bf16_t* O; int ldc; const float* rowss; const float* sw; int swpitch;
    __device__ __forceinline__ void operator()(const f32x4 (&acc)[2][2][4][2], const Unit& u, int wr, int wc, int fr_in, int fq_in, PG8_LAS unsigned char* lds) const {
        int fr = fr_in, fq = fq_in; asm volatile("" : "+v"(fr), "+v"(fq));
        const int row0 = u.pm * BM + wr * 64 + fr, col0 = u.pn * HALF + wc * 32 + 8 * fq;
        f32x4 sv[2][2];
        { const float* sp = sw + (size_t)(u.pm >> 3) * swpitch + u.pn * BM + wc * 32 + 8 * fq;
#pragma unroll
          for (int bj = 0; bj < 2; ++bj)
#pragma unroll
              for (int n = 0; n < 2; ++n) sv[bj][n] = *(const f32x4*)(sp + bj * HALF + 4 * n); }
        float rsd[2][4];
#pragma unroll
        for (int ai = 0; ai < 2; ++ai)
#pragma unroll
            for (int m = 0; m < 4; ++m) rsd[ai][m] = rowss[row0 + ai * HALF + m * 16];
        asm volatile("" ::: "memory");
#pragma unroll
        for (int ai = 0; ai < 2; ++ai)
#pragma unroll
            for (int m = 0; m < 4; ++m) { const int row = row0 + ai * HALF + m * 16; bf16_t* rowp = O + (size_t)row * ldc + col0; float r[8];
                const float rstd = __builtin_amdgcn_rsqf(rsd[ai][m] * (1.f / 2048.f) + 1e-6f);
#pragma unroll
                for (int n = 0; n < 2; ++n)
#pragma unroll
                    for (int j = 0; j < 4; ++j) { const float g = fmaf(acc[ai][0][m][n][j], rstd, sv[0][n][j]), up = fmaf(acc[ai][1][m][n][j], rstd, sv[1][n][j]);
                        r[4 * n + j] = g * __builtin_amdgcn_rcpf(1.f + __builtin_amdgcn_exp2f(-1.4426950408889634f * g)) * up; }
                u32x4 w; w.x = cvt_pk_bf16(r[0], r[1]); w.y = cvt_pk_bf16(r[2], r[3]); w.z = cvt_pk_bf16(r[4], r[5]); w.w = cvt_pk_bf16(r[6], r[7]);
                *(u32x4*)rowp = w; }
    }
};
template <int NH, bool BIN, bool BOUT>
struct EpiResid {
    static constexpr bool PERM = true, AFTER_DRAIN = false, PREFETCH = false;
    const void* base; void* out; int ldc; const float* gate; int gpitch;
    float* rowss; const float* g1; const float* sc1; bf16_t* h1; const float* g2; const float* sc2; bf16_t* h2;
    __device__ __forceinline__ void operator()(const f32x4 (&acc)[2][2][4][2], const Unit& u, int wr, int wc, int fr_in, int fq_in, PG8_LAS unsigned char* lds) const {
        int fr = fr_in, fq = fq_in; asm volatile("" : "+v"(fr), "+v"(fq));
        const int row0 = u.pm * BM + wr * 64 + fr, col0 = u.pn * BM + wc * 32 + 8 * fq;
        const size_t boff = (size_t)(u.pm >> 3) * gpitch + col0;
        f32x4 gv[2][2], s1[2][2], s2[2][2];
#pragma unroll
        for (int bj = 0; bj < 2; ++bj)
#pragma unroll
            for (int n = 0; n < 2; ++n) { const int co = bj * HALF + 4 * n; gv[bj][n] = *(const f32x4*)(gate + boff + co);
                if (NH >= 1) s1[bj][n] = *(const f32x4*)(g1 + col0 + co) * (*(const f32x4*)(sc1 + boff + co) + 1.f);
                if (NH >= 2) s2[bj][n] = *(const f32x4*)(g2 + col0 + co) * (*(const f32x4*)(sc2 + boff + co) + 1.f); }
        constexpr int MB = (NH == 2) ? 2 : (BIN ? 4 : ((NH >= 1) ? 2 : 4));
#pragma unroll
        for (int am = 0; am < 8; am += MB) { const int ai = am >> 2;
            f32x4 bsv[MB][2][BIN ? 1 : 2];
#pragma unroll
            for (int mm = 0; mm < MB; ++mm) { const size_t off = (size_t)(row0 + ai * HALF + ((am & 3) + mm) * 16) * ldc + col0;
#pragma unroll
                for (int bj = 0; bj < 2; ++bj) {
                    if (BIN) bsv[mm][bj][0] = *(const f32x4*)((const bf16_t*)base + off + bj * HALF);
                    else {
#pragma unroll
                        for (int n = 0; n < (BIN ? 1 : 2); ++n) bsv[mm][bj][n] = *(const f32x4*)((const float*)base + off + bj * HALF + 4 * n); } } }
            asm volatile("" ::: "memory");
#pragma unroll
            for (int mm = 0; mm < MB; ++mm) { const int m = (am & 3) + mm; const int row = row0 + ai * HALF + m * 16; const size_t off = (size_t)row * ldc + col0; float q = 0.f;
#pragma unroll
                for (int bj = 0; bj < 2; ++bj) { f32x4 x[2];
                    if (BIN) { const u32x4 r = __builtin_bit_cast(u32x4, bsv[mm][bj][0]);
                        x[0] = (f32x4){__uint_as_float(r.x << 16), __uint_as_float(r.x & 0xffff0000u), __uint_as_float(r.y << 16), __uint_as_float(r.y & 0xffff0000u)};
                        x[1] = (f32x4){__uint_as_float(r.z << 16), __uint_as_float(r.z & 0xffff0000u), __uint_as_float(r.w << 16), __uint_as_float(r.w & 0xffff0000u)}; }
                    else { x[0] = bsv[mm][bj][0]; x[1] = bsv[mm][bj][BIN ? 0 : 1]; }
#pragma unroll
                    for (int n = 0; n < 2; ++n) { x[n] = x[n] + gv[bj][n] * acc[ai][bj][m][n];
                        q += (x[n][0] * x[n][0] + x[n][1] * x[n][1]) + (x[n][2] * x[n][2] + x[n][3] * x[n][3]); }
                    if (!u.dry) {
                        if (BOUT) { u32x4 w; w.x = cvt_pk_bf16(x[0][0], x[0][1]); w.y = cvt_pk_bf16(x[0][2], x[0][3]); w.z = cvt_pk_bf16(x[1][0], x[1][1]); w.w = cvt_pk_bf16(x[1][2], x[1][3]);
                            *(u32x4*)((bf16_t*)out + off + bj * HALF) = w; }
                        else { *(f32x4*)((float*)out + off + bj * HALF) = x[0]; *(f32x4*)((float*)out + off + bj * HALF + 4) = x[1]; } }
                    if (NH >= 1) { const f32x4 a0 = x[0] * s1[bj][0], a1 = x[1] * s1[bj][1]; u32x4 w; w.x = cvt_pk_bf16(a0[0], a0[1]); w.y = cvt_pk_bf16(a0[2], a0[3]); w.z = cvt_pk_bf16(a1[0], a1[1]); w.w = cvt_pk_bf16(a1[2], a1[3]);
                        if (!u.dry) *(u32x4*)(h1 + off + bj * HALF) = w; }
                    if (NH >= 2) { const f32x4 a0 = x[0] * s2[bj][0], a1 = x[1] * s2[bj][1]; u32x4 w; w.x = cvt_pk_bf16(a0[0], a0[1]); w.y = cvt_pk_bf16(a0[2], a0[3]); w.z = cvt_pk_bf16(a1[0], a1[1]); w.w = cvt_pk_bf16(a1[2], a1[3]);
                        if (!u.dry) *(u32x4*)(h2 + off + bj * HALF) = w; } }
                if (NH >= 1) { q += __shfl_xor(q, 16); q += __shfl_xor(q, 32); if (fq == 0 && !u.dry) __hip_atomic_fetch_add(rowss + row, q, __ATOMIC_RELAXED, __HIP_MEMORY_SCOPE_AGENT); } }
            asm volatile("" ::: "memory");
        }
    }
};
template <class Epi, class Sched, bool ALIGN_EPI = false, bool SP2 = false>
__device__ __forceinline__ void gemm_phase(PG8_LAS unsigned char* lds, const Gemm g, const Sched& S, const Epi& E) {
    const int tid = threadIdx.x, wid = __builtin_amdgcn_readfirstlane(tid >> 6), lane = tid & 63, wr = wid >> 2, wc = wid & 3, fr = lane & 15, fq = lane >> 4;
    const int K = g.K, nt = K / BK;
    unsigned voffA[2], voffB[2];
#pragma unroll
    for (int i = 0; i < 2; ++i) { int R, C; stage_rc(tid * 16 + i * 8192, R, C); const int Rb = Epi::PERM ? ((R & ~31) + perm32(R & 31)) : R;
        voffA[i] = (unsigned)(R * K + C) * 2u; voffB[i] = (unsigned)(Rb * K + C) * 2u; }
    const size_t kstep = (size_t)(BK * 2);
    const size_t hstep = (size_t)HALF * K * 2;
    const size_t tstep = 2 * hstep;
    const unsigned ldsw = (unsigned)wid * 1024u;
    const int aoff = lds_byte(wr * 64 + fr, fq * 8), boff = lds_byte(wc * 32 + fr, fq * 8);
#define PG8_SA(b, h) (((b) * 2 + (h)) * HTB)
#define PG8_SB(b, h) ((4 + (b) * 2 + (h)) * HTB)
#define PG8_STAGE(bufoff, gbase, voff) do { _Pragma("unroll") for (int _i = 0; _i < 2; ++_i) \
        __builtin_amdgcn_global_load_lds((const unsigned*)((const char*)(gbase) + (voff)[_i]), (PG8_LAS unsigned*)(lds + (bufoff) + ldsw + _i * 8192), 16, 0, 0); } while (0)
#define PG8_LDA(dst, b, h) do { _Pragma("unroll") for (int m = 0; m < 4; ++m) _Pragma("unroll") for (int k = 0; k < 2; ++k) dst[m][k] = *(const PG8_LAS bf16x8*)(lds + PG8_SA(b, h) + aoff + m * 2048 + k * 1024); } while (0)
#define PG8_LDB(dst, b, h) do { _Pragma("unroll") for (int n = 0; n < 2; ++n) _Pragma("unroll") for (int k = 0; k < 2; ++k) dst[n][k] = *(const PG8_LAS bf16x8*)(lds + PG8_SB(b, h) + boff + n * 2048 + k * 1024); } while (0)
#define PG8_MMA(ai, bj, At, Bt) do { __builtin_amdgcn_s_setprio(1); _Pragma("unroll") for (int m = 0; m < 4; ++m) _Pragma("unroll") for (int n = 0; n < 2; ++n) _Pragma("unroll") for (int k = 0; k < 2; ++k) \
        acc[ai][bj][m][n] = __builtin_amdgcn_mfma_f32_16x16x32_bf16(Bt[n][k], At[m][k], acc[ai][bj][m][n], 0, 0, 0); __builtin_amdgcn_s_setprio(0); } while (0)
#define PG8_WAIT_V(n) asm volatile("s_waitcnt vmcnt(" #n ")" ::: "memory")
#define PG8_WAIT_L(n) asm volatile("s_waitcnt lgkmcnt(" #n ")" ::: "memory")
#define PG8_BAR __builtin_amdgcn_s_barrier()
#define PG8_SCHED __builtin_amdgcn_sched_barrier(0)
    Unit cur, nxt; int ui = 0;
    if (!S.next(0, cur)) return;
    f32x4 acc[2][2][4][2];
#pragma unroll
    for (int a = 0; a < 2; ++a)
#pragma unroll
        for (int b = 0; b < 2; ++b)
#pragma unroll
            for (int m = 0; m < 4; ++m)
#pragma unroll
                for (int n = 0; n < 2; ++n) acc[a][b][m][n] = (f32x4){0.f, 0.f, 0.f, 0.f};
    bf16x8 At[4][2], B0[2][2], B1[2][2];
    const char* cA = (const char*)g.A + (size_t)cur.pm * tstep; const char* cB = (const char*)g.Bt + (size_t)cur.pn * tstep;
    S.a_ready(cur);
    if constexpr (SP2) {
        PG8_STAGE(PG8_SB(0, 0), cB, voffB); PG8_STAGE(PG8_SB(0, 1), cB + hstep, voffB); PG8_STAGE(PG8_SA(0, 0), cA, voffA); PG8_STAGE(PG8_SA(0, 1), cA + hstep, voffA);
        if (wr == 1) PG8_BAR;
        PG8_WAIT_V(2); PG8_BAR;
        PG8_STAGE(PG8_SB(1, 0), cB + kstep, voffB); PG8_STAGE(PG8_SA(1, 0), cA + kstep, voffA); PG8_STAGE(PG8_SB(1, 1), cB + hstep + kstep, voffB);
        PG8_WAIT_V(6); PG8_BAR;
    } else {
        PG8_STAGE(PG8_SB(0, 0), cB, voffB); PG8_STAGE(PG8_SA(0, 0), cA, voffA); PG8_STAGE(PG8_SB(0, 1), cB + hstep, voffB); PG8_STAGE(PG8_SA(0, 1), cA + hstep, voffA);
        if (wr == 1) PG8_BAR;
        PG8_WAIT_V(4); PG8_BAR;
        PG8_STAGE(PG8_SB(1, 0), cB + kstep, voffB); PG8_STAGE(PG8_SA(1, 0), cA + kstep, voffA); PG8_STAGE(PG8_SB(1, 1), cB + hstep + kstep, voffB);
        PG8_WAIT_V(6); PG8_BAR;
    }
    for (;;) {
        const bool has_next = S.next(ui + 1, nxt);
        const char* nA = has_next ? (const char*)g.A + (size_t)nxt.pm * tstep : cA; const char* nB = has_next ? (const char*)g.Bt + (size_t)nxt.pn * tstep : cB;
        for (int t = 0; t < nt; t += 2) {
            const bool last = (t == nt - 2);
            const char* a1 = cA + (size_t)(t + 1) * kstep;
            const char* a2 = last ? nA : cA + (size_t)(t + 2) * kstep; const char* b2 = last ? nB : cB + (size_t)(t + 2) * kstep;
            const char* a3 = a2 + kstep; const char* b3 = b2 + kstep;
            if (last && has_next) S.a_ready(nxt);
            if constexpr (SP2) {
            PG8_LDB(B0, 0, 0); PG8_LDB(B1, 0, 1); PG8_SCHED; PG8_LDA(At, 0, 0); PG8_STAGE(PG8_SA(1, 1), a1 + hstep, voffA);
            PG8_WAIT_V(8); PG8_WAIT_L(0); PG8_BAR; PG8_MMA(0, 0, At, B0); PG8_MMA(0, 1, At, B1); PG8_BAR; PG8_SCHED;
            PG8_LDA(At, 0, 1); PG8_STAGE(PG8_SB(0, 0), b2, voffB); PG8_STAGE(PG8_SB(0, 1), b2 + hstep, voffB); PG8_STAGE(PG8_SA(0, 0), a2, voffA);
            PG8_WAIT_V(8); PG8_WAIT_L(0); PG8_BAR; PG8_MMA(1, 0, At, B0); PG8_MMA(1, 1, At, B1); PG8_BAR; PG8_SCHED;
            PG8_LDB(B0, 1, 0); PG8_LDB(B1, 1, 1); PG8_SCHED; PG8_LDA(At, 1, 0); PG8_STAGE(PG8_SA(0, 1), a2 + hstep, voffA);
            PG8_WAIT_V(8); PG8_WAIT_L(0); PG8_BAR; PG8_MMA(0, 0, At, B0); PG8_MMA(0, 1, At, B1); PG8_BAR; PG8_SCHED;
            PG8_LDA(At, 1, 1); PG8_STAGE(PG8_SB(1, 0), b3, voffB); PG8_STAGE(PG8_SB(1, 1), b3 + hstep, voffB); PG8_STAGE(PG8_SA(1, 0), a3, voffA);
            PG8_WAIT_V(8); PG8_WAIT_L(0); PG8_BAR; PG8_MMA(1, 0, At, B0); PG8_MMA(1, 1, At, B1); PG8_BAR; PG8_SCHED;
            } else {
            PG8_LDB(B0, 0, 0); PG8_SCHED; PG8_LDA(At, 0, 0); PG8_STAGE(PG8_SA(1, 1), a1 + hstep, voffA);
            PG8_WAIT_L(8); PG8_BAR; PG8_WAIT_L(0); PG8_MMA(0, 0, At, B0); PG8_BAR; PG8_SCHED;
            PG8_LDB(B1, 0, 1); PG8_STAGE(PG8_SB(0, 0), b2, voffB);
            PG8_BAR; PG8_WAIT_L(0); PG8_MMA(0, 1, At, B1); PG8_BAR;
            PG8_LDA(At, 0, 1); PG8_STAGE(PG8_SA(0, 0), a2, voffA);
            PG8_BAR; PG8_WAIT_L(0); PG8_MMA(1, 0, At, B0); PG8_BAR; PG8_SCHED;
            PG8_STAGE(PG8_SB(0, 1), b2 + hstep, voffB);
            PG8_WAIT_V(6); PG8_BAR; PG8_MMA(1, 1, At, B1); PG8_BAR;
            PG8_LDB(B0, 1, 0); PG8_SCHED; PG8_LDA(At, 1, 0); PG8_STAGE(PG8_SA(0, 1), a2 + hstep, voffA);
            PG8_WAIT_L(8); PG8_BAR; PG8_WAIT_L(0); PG8_MMA(0, 0, At, B0); PG8_BAR; PG8_SCHED;
            PG8_LDB(B1, 1, 1); PG8_STAGE(PG8_SB(1, 0), b3, voffB);
            PG8_BAR; PG8_WAIT_L(0); PG8_MMA(0, 1, At, B1); PG8_BAR;
            PG8_LDA(At, 1, 1); PG8_STAGE(PG8_SA(1, 0), a3, voffA);
            PG8_BAR; PG8_WAIT_L(0); PG8_MMA(1, 0, At, B0); PG8_BAR; PG8_SCHED;
            PG8_STAGE(PG8_SB(1, 1), b3 + hstep, voffB);
            PG8_WAIT_V(6); PG8_BAR; PG8_MMA(1, 1, At, B1); PG8_BAR;
            }
        }
        if constexpr (ALIGN_EPI) { if (wr == 0) PG8_BAR; }
        if constexpr (!Epi::AFTER_DRAIN) { E(acc, cur, wr, wc, fr, fq, lds); S.done(cur); }
        if (!has_next) break;
#pragma unroll
        for (int a = 0; a < 2; ++a)
#pragma unroll
            for (int b = 0; b < 2; ++b)
#pragma unroll
                for (int m = 0; m < 4; ++m)
#pragma unroll
                    for (int n = 0; n < 2; ++n) acc[a][b][m][n] = (f32x4){0.f, 0.f, 0.f, 0.f};
        cur = nxt; cA = nA; cB = nB; ++ui;
        if constexpr (ALIGN_EPI) { if (wr == 1) PG8_BAR; }
    }
    PG8_WAIT_V(0);
    if constexpr (!ALIGN_EPI) { if (wr == 0) PG8_BAR; }
    PG8_BAR;
    if constexpr (Epi::AFTER_DRAIN) { E.fused(acc, cur, wr, wc, fr, fq, lds, wid, lane); S.done(cur); }
#undef PG8_SA
#undef PG8_SB
#undef PG8_STAGE
#undef PG8_LDA
#undef PG8_LDB
#undef PG8_MMA
#undef PG8_WAIT_V
#undef PG8_WAIT_L
#undef PG8_BAR
#undef PG8_SCHED
}
}

namespace att {
#define ALAS __attribute__((address_space(3)))
typedef unsigned short bf16_t;
typedef short bf16x8 __attribute__((ext_vector_type(8)));
typedef short s16x4 __attribute__((ext_vector_type(4)));
typedef float f32x16 __attribute__((ext_vector_type(16)));
typedef float f32x4 __attribute__((ext_vector_type(4)));
typedef unsigned u32x4 __attribute__((ext_vector_type(4)));
constexpr int KVBLK = 64, QBLK = 32, SHM_K = 16384, SHM_V = 16384;
constexpr int GRP_BYTES = 2 * SHM_V + 2 * SHM_K + 512;
constexpr int SCR_OFF = 2 * GRP_BYTES;
constexpr int LDS_NEED = SCR_OFF + 8 * 256;
constexpr float SCALE = 0.08838834764831845f, THR = 8.f;
#define KSWZ(row, colB) ((row) * 256 + ((colB) ^ (((row) & 7) << 4)))
#define SBAR() __builtin_amdgcn_sched_barrier(0)
__device__ __forceinline__ int v_st(int k, int c) { const int kk = (k & ~0xC) | ((k & 4) << 1) | ((k & 8) >> 1); return ((kk >> 3) * 4 + (c >> 5)) * 512 + ((kk & 7) * 32 + (c & 31)) * 2; }
__device__ __forceinline__ int v_rd_base(int lane) { return ((lane & 3) << 3) | (((lane >> 2) & 3) << 6) | (((lane >> 4) & 1) << 5) | (((lane >> 5) & 1) << 8); }
__device__ __forceinline__ int crow(int r, int hi) { return (r & 3) + 8 * (r >> 2) + 4 * hi; }
__device__ __forceinline__ unsigned cvtpk(float lo, float hi) { unsigned r; asm volatile("v_cvt_pk_bf16_f32 %0, %1, %2" : "=v"(r) : "v"(lo), "v"(hi)); return r; }
__device__ __forceinline__ void mask_tile(f32x16& p0, f32x16& p1, int dq, unsigned W) {
    const float NEG = -__builtin_inff();
#pragma unroll
    for (int r = 0; r < 16; ++r) { const int c = (r & 3) + 8 * (r >> 2);
        if ((unsigned)(dq - c) >= W) p0[r] = NEG;
        if ((unsigned)(dq - c - 32) >= W) p1[r] = NEG; }
}
__device__ __forceinline__ void partialSM(f32x16& p0, f32x16& p1, float& m_reg, float& mn, float& alpha) {
    float pmax = p0[0];
#pragma unroll
    for (int r = 1; r < 16; ++r) pmax = fmaxf(pmax, p0[r]);
#pragma unroll
    for (int r = 0; r < 16; ++r) pmax = fmaxf(pmax, p1[r]);
    { auto rr = __builtin_amdgcn_permlane32_swap(__float_as_uint(pmax), __float_as_uint(pmax), false, false);
      pmax = fmaxf(__uint_as_float(rr[0]), __uint_as_float(rr[1])); }
    constexpr float C2 = 1.4426950408889634f * SCALE;
    if (__builtin_expect(__all((pmax - m_reg) * SCALE <= THR), 1)) { mn = m_reg; alpha = 1.f; }
    else { mn = fmaxf(m_reg, pmax); alpha = __builtin_amdgcn_exp2f((m_reg - mn) * C2); m_reg = mn; }
    const float mnL = -mn * C2;
#pragma unroll
    for (int r = 0; r < 16; ++r) p0[r] = fmaf(p0[r], C2, mnL);
#pragma unroll
    for (int r = 0; r < 16; ++r) p1[r] = fmaf(p1[r], C2, mnL);
#pragma unroll
    for (int r = 0; r < 16; ++r) p0[r] = __builtin_amdgcn_exp2f(p0[r]);
}
__device__ __forceinline__ void finishSM(f32x16& p0, f32x16& p1, float alpha, float& l_reg, bf16x8& pa0, bf16x8& pa1, bf16x8& pa2, bf16x8& pa3) {
#pragma unroll
    for (int r = 0; r < 16; ++r) p1[r] = __builtin_amdgcn_exp2f(p1[r]);
    float ps = 0;
#pragma unroll
    for (int r = 0; r < 16; ++r) ps += p0[r];
#pragma unroll
    for (int r = 0; r < 16; ++r) ps += p1[r];
    { auto rr = __builtin_amdgcn_permlane32_swap(__float_as_uint(ps), __float_as_uint(ps), false, false);
      ps = __uint_as_float(rr[0]) + __uint_as_float(rr[1]); }
    l_reg = l_reg * alpha + ps;
#define PK4(P, B_, OUT) do { unsigned a0 = cvtpk(P[B_+0], P[B_+1]), a1 = cvtpk(P[B_+2], P[B_+3]);                          \
        unsigned b0 = cvtpk(P[B_+4], P[B_+5]), b1 = cvtpk(P[B_+6], P[B_+7]);                                             \
        auto r0 = __builtin_amdgcn_permlane32_swap(a0, b0, false, false); auto r1 = __builtin_amdgcn_permlane32_swap(a1, b1, false, false); \
        u32x4 w = {r0[0], r1[0], r0[1], r1[1]}; OUT = __builtin_bit_cast(bf16x8, w); } while (0)
    PK4(p0, 0, pa0); PK4(p0, 8, pa1); PK4(p1, 0, pa2); PK4(p1, 8, pa3);
#undef PK4
}
__device__ __forceinline__ void qkt(f32x16& p0, f32x16& p1, const ALAS char* Kb, int r32, int hi, const bf16x8* qr) {
    p0 = f32x16{}; p1 = f32x16{};
    const ALAS char* kb[4];
#pragma unroll
    for (int dd = 0; dd < 4; ++dd) kb[dd] = Kb + KSWZ(r32, (dd * 16 + hi * 8) * 2);
#pragma unroll
    for (int d0 = 0; d0 < 8; ++d0) { const ALAS char* a = kb[d0 & 3] + (d0 >> 2) * 128;
        const bf16x8 b0 = *(const ALAS bf16x8*)a;
        const bf16x8 b1 = *(const ALAS bf16x8*)(a + 32 * 256);
        p0 = __builtin_amdgcn_mfma_f32_32x32x16_bf16(b0, qr[d0], p0, 0, 0, 0);
        p1 = __builtin_amdgcn_mfma_f32_32x32x16_bf16(b1, qr[d0], p1, 0, 0, 0); }
}
__device__ __forceinline__ void pv_tile(f32x16* o, int vb0, bf16x8 pa0, bf16x8 pa1, bf16x8 pa2, bf16x8 pa3) {
#define TRRD(dst, off) asm volatile("ds_read_b64_tr_b16 %0, %1 offset:%2" : "=&v"(dst) : "v"(vb0), "i"(off) : "memory")
#define PV_KS(ks, pa) do { s16x4 l0, l1, l2, l3, h0, h1, h2, h3; constexpr int b_ = (ks) * 4096;   \
        TRRD(l0, b_); TRRD(h0, b_ + 2048); TRRD(l1, b_ + 512); TRRD(h1, b_ + 512 + 2048); TRRD(l2, b_ + 1024); TRRD(h2, b_ + 1024 + 2048); TRRD(l3, b_ + 1536); TRRD(h3, b_ + 1536 + 2048); \
        asm volatile("s_waitcnt lgkmcnt(0)" ::: "memory"); SBAR();   \
        o[0] = __builtin_amdgcn_mfma_f32_32x32x16_bf16(pa, (bf16x8){l0[0], l0[1], l0[2], l0[3], h0[0], h0[1], h0[2], h0[3]}, o[0], 0, 0, 0);   \
        o[1] = __builtin_amdgcn_mfma_f32_32x32x16_bf16(pa, (bf16x8){l1[0], l1[1], l1[2], l1[3], h1[0], h1[1], h1[2], h1[3]}, o[1], 0, 0, 0);   \
        o[2] = __builtin_amdgcn_mfma_f32_32x32x16_bf16(pa, (bf16x8){l2[0], l2[1], l2[2], l2[3], h2[0], h2[1], h2[2], h2[3]}, o[2], 0, 0, 0);   \
        o[3] = __builtin_amdgcn_mfma_f32_32x32x16_bf16(pa, (bf16x8){l3[0], l3[1], l3[2], l3[3], h3[0], h3[1], h3[2], h3[3]}, o[3], 0, 0, 0); } while (0)
    PV_KS(0, pa0); PV_KS(1, pa1); PV_KS(2, pa2); PV_KS(3, pa3);
#undef PV_KS
#undef TRRD
}
struct Unit { const bf16_t* Q; const bf16_t* K; const bf16_t* V; bf16_t* O; long ldq, ldk; int P0, W, j_lo, NT; float* lse; long lse_ld; int dry; };
constexpr int FB_OFF = LDS_NEED;
template <bool SHARED, bool BIAS>
__device__ __forceinline__ void attn_unit(const Unit& U, ALAS char* lds) {
    const int tid = threadIdx.x, wid = __builtin_amdgcn_readfirstlane(tid >> 6), lane = tid & 63, r32 = lane & 31, hi = lane >> 5;
    const int grp = SHARED ? 0 : (wid >> 2), gw = SHARED ? wid : (wid & 3), gtid = SHARED ? tid : (tid & 255);
    ALAS char* V_lds = lds + grp * GRP_BYTES; ALAS char* K_lds = V_lds + 2 * SHM_V;
    ALAS float* ws = (ALAS float*)(lds + SCR_OFF) + wid * 64; ALAS float* li_l = ws; ALAS float* al_l = ws + 32;
    constexpr int NST = SHARED ? 2 : 4, RSTEP = SHARED ? 32 : 16;
    const int sr = gtid >> 4, sc = (gtid & 15) * 8;
    bf16x8 qr[8];
    { const unsigned qoff = (unsigned)(gw * QBLK + r32) * (unsigned)U.ldq + hi * 8;
#pragma unroll
      for (int d0 = 0; d0 < 8; ++d0) qr[d0] = *(const bf16x8*)(U.Q + (qoff + d0 * 16)); }
    bf16x8 stk[NST], stv[NST];
    const unsigned soff = (unsigned)sr * (unsigned)U.ldk + sc, sstep = (unsigned)RSTEP * (unsigned)U.ldk;
#define LOADT(t) do { const size_t k0_ = (size_t)(U.j_lo + (t)) * KVBLK; const bf16_t* kt_ = U.K + k0_ * U.ldk; const bf16_t* vt_ = U.V + k0_ * U.ldk; \
        _Pragma("unroll") for (int i = 0; i < NST; ++i) { stk[i] = *(const bf16x8*)(kt_ + (soff + i * sstep)); stv[i] = *(const bf16x8*)(vt_ + (soff + i * sstep)); } \
        } while (0)
#define WRITET(bf) do { _Pragma("unroll") for (int i = 0; i < NST; ++i) { const int row_ = sr + i * RSTEP; \
        *(ALAS bf16x8*)(K_lds + (bf) * SHM_K + KSWZ(row_, sc * 2)) = stk[i]; *(ALAS bf16x8*)(V_lds + (bf) * SHM_V + v_st(row_, sc)) = stv[i]; } \
        } while (0)
    LOADT(0); WRITET(0);
    if (U.NT > 1) LOADT(1);
    const int qlo = U.P0 + gw * QBLK, qm = qlo + r32 - 4 * hi;
    float m_reg = -1e30f, l_reg = 0.f; f32x16 o[4] = {};
    const int vbase = (int)(uintptr_t)V_lds + v_rd_base(lane);
    for (int t = 0; t < U.NT; ++t) {
        asm volatile("s_waitcnt lgkmcnt(0)\n\ts_barrier" ::: "memory");
        const int bf = t & 1;
        if (t + 1 < U.NT) WRITET(bf ^ 1);
        if (t + 2 < U.NT) LOADT(t + 2);
        const int kb = (U.j_lo + t) * KVBLK;
        const bool act = (kb <= qlo + QBLK - 1) && (kb + KVBLK - 1 >= qlo - U.W + 1);
        if (act) {
            f32x16 p0, p1; float mn, alpha; bf16x8 pa0, pa1, pa2, pa3;
            qkt(p0, p1, K_lds + bf * SHM_K, r32, hi, qr);
            if (BIAS) { const ALAS char* bp = lds + FB_OFF + kb * 4 + hi * 16;
#pragma unroll
                for (int g = 0; g < 4; ++g) { const f32x4 b0 = *(const ALAS f32x4*)(bp + g * 32), b1 = *(const ALAS f32x4*)(bp + 128 + g * 32);
#pragma unroll
                    for (int j = 0; j < 4; ++j) { p0[4 * g + j] += b0[j]; p1[4 * g + j] += b1[j]; } } }
            if (kb + KVBLK - 1 > qlo || kb <= qlo + QBLK - 1 - U.W) mask_tile(p0, p1, qm - kb, (unsigned)U.W);
            partialSM(p0, p1, m_reg, mn, alpha);
            if (__any(alpha < 1.f)) { if (hi == 0) al_l[r32] = alpha; asm volatile("s_waitcnt lgkmcnt(0)" ::: "memory");
#pragma unroll
                for (int d_ = 0; d_ < 4; ++d_)
#pragma unroll
                    for (int r = 0; r < 16; ++r) o[d_][r] *= al_l[crow(r, hi)]; }
            finishSM(p0, p1, alpha, l_reg, pa0, pa1, pa2, pa3); SBAR();
            pv_tile(o, vbase + bf * SHM_V, pa0, pa1, pa2, pa3);
        }
    }
    if (hi == 0) { li_l[r32] = l_reg; if (U.lse && !U.dry) U.lse[(size_t)(gw * QBLK + r32) * U.lse_ld] = m_reg * SCALE + __logf(l_reg); }
    asm volatile("s_waitcnt lgkmcnt(0)" ::: "memory");
    float rli[16];
#pragma unroll
    for (int r = 0; r < 16; ++r) rli[r] = __builtin_amdgcn_rcpf(li_l[crow(r, hi)]);
    const unsigned ooff = (unsigned)(gw * QBLK + 4 * hi) * (unsigned)U.ldq + r32;
#pragma unroll
    for (int r = 0; r < 16; ++r) { const unsigned orow = (r & 3) + 8 * (r >> 2);
#pragma unroll
        for (int d0 = 0; d0 < 4; ++d0) { const float v = o[d0][r] * rli[r]; const float vn = __shfl_xor(v, 1);
            if ((r32 & 1) == 0 && !U.dry) *(unsigned*)(U.O + (ooff + orow * (unsigned)U.ldq + d0 * 32)) = cvtpk(v, vn); } }
    asm volatile("s_waitcnt lgkmcnt(0)\n\ts_barrier" ::: "memory");
#undef LOADT
#undef WRITET
}
template <bool BIAS>
__device__ __forceinline__ void attn_unit_pipe(const Unit& U, ALAS char* lds) {
    int tid = threadIdx.x; asm volatile("" : "+v"(tid));
    const int wid = __builtin_amdgcn_readfirstlane(tid >> 6), lane = tid & 63, r32 = lane & 31, hi = lane >> 5;
    ALAS char* V_lds = lds; ALAS char* K_lds = lds + 2 * SHM_V;
    ALAS float* ws = (ALAS float*)(lds + SCR_OFF) + wid * 64; ALAS float* li_l = ws; ALAS float* al_l = ws + 32;
    constexpr int NST = 2, RSTEP = 32;
    const int sr = tid >> 4, sc = (tid & 15) * 8;
    bf16x8 qr[8];
    { const unsigned qoff = (unsigned)(wid * QBLK + r32) * (unsigned)U.ldq + hi * 8;
#pragma unroll
      for (int d0 = 0; d0 < 8; ++d0) qr[d0] = *(const bf16x8*)(U.Q + (qoff + d0 * 16)); }
    bf16x8 stk[NST], stv[NST];
    const unsigned soff = (unsigned)sr * (unsigned)U.ldk + sc, sstep = (unsigned)RSTEP * (unsigned)U.ldk;
#define LOADT(t) do { const size_t k0_ = (size_t)(U.j_lo + (t)) * KVBLK; const bf16_t* kt_ = U.K + k0_ * U.ldk; const bf16_t* vt_ = U.V + k0_ * U.ldk; \
        _Pragma("unroll") for (int i = 0; i < NST; ++i) { stk[i] = *(const bf16x8*)(kt_ + (soff + i * sstep)); stv[i] = *(const bf16x8*)(vt_ + (soff + i * sstep)); } \
        } while (0)
#define WRITET(slot) do { _Pragma("unroll") for (int i = 0; i < NST; ++i) { const int row_ = sr + i * RSTEP; \
        *(ALAS bf16x8*)(K_lds + (slot) * SHM_K + KSWZ(row_, sc * 2)) = stk[i]; *(ALAS bf16x8*)(V_lds + (slot) * SHM_V + v_st(row_, sc)) = stv[i]; } \
        } while (0)
#define BARRIER() asm volatile("s_waitcnt lgkmcnt(0)\n\ts_barrier" ::: "memory")
    const int NT = U.NT;
    const int qlo = U.P0 + wid * QBLK, qm = qlo + r32 - 4 * hi;
    float m_reg = -1e30f, l_reg = 0.f; f32x16 o[4] = {};
    const int vbase = (int)(uintptr_t)V_lds + v_rd_base(lane);
#define KBASE(t) ((U.j_lo + (t)) * KVBLK)
#define ACTT(t) ((KBASE(t) <= qlo + QBLK - 1) && (KBASE(t) + KVBLK - 1 >= qlo - U.W + 1))
#define QKT(P0_, P1_, t) do { if (ACTT(t)) qkt(P0_, P1_, K_lds + ((t) & 1) * SHM_K, r32, hi, qr); else { const float NEG_ = -__builtin_inff(); \
        _Pragma("unroll") for (int r = 0; r < 16; ++r) { P0_[r] = NEG_; P1_[r] = NEG_; } } } while (0)
#define BMASK(P0_, P1_, t) do { if (ACTT(t)) { const int kb_ = KBASE(t); \
        if (BIAS) { const ALAS char* bp = lds + FB_OFF + kb_ * 4 + hi * 16; \
            _Pragma("unroll") for (int g = 0; g < 4; ++g) { const f32x4 b0 = *(const ALAS f32x4*)(bp + g * 32), b1 = *(const ALAS f32x4*)(bp + 128 + g * 32); \
                _Pragma("unroll") for (int j = 0; j < 4; ++j) { P0_[4 * g + j] += b0[j]; P1_[4 * g + j] += b1[j]; } } } \
        if (kb_ + KVBLK - 1 > qlo || kb_ <= qlo + QBLK - 1 - U.W) mask_tile(P0_, P1_, qm - kb_, (unsigned)U.W); } } while (0)
#define RESC(a) do { if (__any((a) < 1.f)) { if (hi == 0) al_l[r32] = (a); asm volatile("s_waitcnt lgkmcnt(0)" ::: "memory"); \
        _Pragma("unroll") for (int d_ = 0; d_ < 4; ++d_) _Pragma("unroll") for (int r = 0; r < 16; ++r) o[d_][r] *= al_l[crow(r, hi)]; } } while (0)
    f32x16 pA0, pA1, pB0, pB1; float mnA, mnB, alA, alB; bf16x8 pa0, pa1, pa2, pa3;
    LOADT(0); WRITET(0); BARRIER();
    LOADT(1);
    QKT(pA0, pA1, 0); BMASK(pA0, pA1, 0); partialSM(pA0, pA1, m_reg, mnA, alA);
    WRITET(1); BARRIER();
    if (NT > 2) LOADT(2);
#define HALF_STEP(PX0, PX1, mnX, alX, PY0, PY1, alY, t) do { \
        SBAR(); QKT(PX0, PX1, t); \
        finishSM(PY0, PY1, alY, l_reg, pa0, pa1, pa2, pa3); SBAR(); \
        if (ACTT((t) - 1)) pv_tile(o, vbase + (((t) - 1) & 1) * SHM_V, pa0, pa1, pa2, pa3); \
        BMASK(PX0, PX1, t); partialSM(PX0, PX1, m_reg, mnX, alX); \
        BARRIER(); \
        if ((t) + 1 < NT) { WRITET(((t) + 1) & 1); if ((t) + 2 < NT) LOADT((t) + 2); } \
        RESC(alX); BARRIER(); } while (0)
    for (int t = 1; t + 1 < NT; t += 2) {
        HALF_STEP(pB0, pB1, mnB, alB, pA0, pA1, alA, t);
        HALF_STEP(pA0, pA1, mnA, alA, pB0, pB1, alB, t + 1);
    }
    HALF_STEP(pB0, pB1, mnB, alB, pA0, pA1, alA, NT - 1);
    finishSM(pB0, pB1, alB, l_reg, pa0, pa1, pa2, pa3); SBAR();
    if (ACTT(NT - 1)) pv_tile(o, vbase + ((NT - 1) & 1) * SHM_V, pa0, pa1, pa2, pa3);
#undef HALF_STEP
#undef RESC
#undef BMASK
#undef QKT
#undef ACTT
#undef KBASE
    if (hi == 0) li_l[r32] = l_reg;
    asm volatile("s_waitcnt lgkmcnt(0)" ::: "memory");
    float rli[16];
#pragma unroll
    for (int r = 0; r < 16; ++r) rli[r] = __builtin_amdgcn_rcpf(li_l[crow(r, hi)]);
    const unsigned ooff = (unsigned)(wid * QBLK + 4 * hi) * (unsigned)U.ldq + r32;
#pragma unroll
    for (int r = 0; r < 16; ++r) { const unsigned orow = (r & 3) + 8 * (r >> 2);
#pragma unroll
        for (int d0 = 0; d0 < 4; ++d0) { const float v = o[d0][r] * rli[r]; const float vn = __shfl_xor(v, 1);
            if ((r32 & 1) == 0 && !U.dry) *(unsigned*)(U.O + (ooff + orow * (unsigned)U.ldq + d0 * 32)) = cvtpk(v, vn); } }
    BARRIER();
#undef BARRIER
#undef LOADT
#undef WRITET
}
#undef SBAR
}

constexpr int BATCH = 16, SEQ = 2048, DM = 2048, M = BATCH * SEQ, HD = 128;
constexpr int NQKV = 9216, WA = 1024, DFF = 5632, NFFN = 2 * DFF, NKV = 4096, NKVF = 4352;
constexpr int MODS_LD = 28672;
constexpr float EPS = 1e-6f;
constexpr int NWAVES = 8, NPHASE = 13;
#ifndef PROBE_DUP
#define PROBE_DUP 0
#endif
#ifndef MK_N_LAUNCHES
#define MK_N_LAUNCHES 1
#endif
constexpr size_t MiB = 1u << 20;
constexpr size_t WS_ROPE = 1 * MiB, WS_MODS = 2 * MiB, WS_LOGF = 4 * MiB, WS_FB = 6 * MiB, WS_LSE = 8 * MiB;
constexpr size_t WS_WQKV = 16 * MiB, WS_WOA = 52 * MiB, WS_WKV = 56 * MiB, WS_WQB = 73 * MiB, WS_WOB = 81 * MiB, WS_WFI = 89 * MiB, WS_WFO = 177 * MiB;
constexpr size_t WS_H = 224 * MiB, WS_BIG = 352 * MiB, WS_OCOMB = 928 * MiB, WS_END = 992 * MiB;
constexpr size_t WS_H2 = 704 * MiB, WS_QB = 832 * MiB, WS_KV = 352 * MiB;
constexpr size_t WS_XB = 704 * MiB;
constexpr size_t WS_SW = 11 * MiB, WS_RSS = 13 * MiB;
constexpr size_t SW_OFF0 = 0, SW_OFF1 = 16 * 11264, SW_OFF2 = SW_OFF1 + 16 * 4352, SW_OFF3 = SW_OFF2 + 16 * 2048;
constexpr int LDS_BYTES = 147456;

#define LAS __attribute__((address_space(3)))
typedef unsigned short bf16;
#define XB_TMO      128
#define XB_XCNT(j)  (256  + 64 * (j))
#define XB_XSUB(j)  (1280 + 64 * (j))
#define XB_XGEN(j)  (2304 + 64 * (j))
#define XB_TOP      3328
#define XB_TOPGEN   3392
#define XCD_BAR_WORDS 3456
#define XB_SPIN_CAP (1u << 18)

__device__ __forceinline__ unsigned xb_ld(unsigned* p)              { return __hip_atomic_load(p, __ATOMIC_RELAXED, __HIP_MEMORY_SCOPE_AGENT); }
__device__ __forceinline__ unsigned xb_add(unsigned* p, unsigned v) { return __hip_atomic_fetch_add(p, v, __ATOMIC_RELAXED, __HIP_MEMORY_SCOPE_AGENT); }
__device__ __forceinline__ unsigned xb_xcc_id() { return (unsigned)__builtin_amdgcn_s_getreg((3 << 11) | 20) & 0xFu; }
#define XB_SPIN(cond, bar) do { unsigned _sp = 0; while (cond) { __builtin_amdgcn_s_sleep(1); \
    if ((++_sp & 255u) == 0u) { if (xb_ld(&(bar)[XB_TMO])) break; if (_sp > XB_SPIN_CAP) { atomicAdd(&(bar)[XB_TMO], 1u); break; } } } } while (0)

struct XcdBarrier {
    unsigned* bar; unsigned x;
    volatile LAS unsigned* st;
};

__device__ __forceinline__ XcdBarrier xcd_barrier_post(unsigned* bar, volatile LAS unsigned* st) {
    XcdBarrier b; b.bar = bar; b.x = xb_xcc_id(); b.st = st;
    if (threadIdx.x == 0) (void)xb_add(&bar[XB_XCNT(b.x)], 1u);
    return b;
}
__device__ __forceinline__ void xcd_barrier_complete(unsigned* bar, unsigned x, unsigned& nloc, unsigned& nx) {
    const unsigned G = gridDim.x * gridDim.y * gridDim.z;
    unsigned sum, cnt, mine, sp = 0u;
    for (;;) {
        sum = 0u; cnt = 0u; mine = 0u;
#pragma unroll
        for (unsigned j = 0; j < 16; ++j) { const unsigned c = xb_ld(&bar[XB_XCNT(j)]); sum += c; cnt += (c > 0u) ? 1u : 0u; mine = (j == x) ? c : mine; }
        if (sum == G) break;
        __builtin_amdgcn_s_sleep(1);
        if ((++sp & 255u) == 0u) { if (xb_ld(&bar[XB_TMO])) break; if (sp > XB_SPIN_CAP) { atomicAdd(&bar[XB_TMO], 1u); break; } }
    }
    nloc = mine > 0u ? mine : 1u; nx = cnt > 0u ? cnt : 1u;
}

__device__ __forceinline__ void xcd_barrier(const XcdBarrier& b) {
    asm volatile("s_waitcnt vmcnt(0)" ::: "memory");
    __syncthreads();
    if (threadIdx.x == 0) {
        unsigned* bar = b.bar;
        __builtin_amdgcn_s_waitcnt(0);
        unsigned nloc = b.st[0], nx = b.st[1];
        if (nloc == 0u) { xcd_barrier_complete(bar, b.x, nloc, nx); b.st[0] = nloc; b.st[1] = nx; }
        const unsigned old = xb_add(&bar[XB_XSUB(b.x)], 1u);
        const unsigned gen = old / nloc;
        if (old + 1u == (gen + 1u) * nloc) {
            __builtin_amdgcn_fence(__ATOMIC_RELEASE, "agent");
            asm volatile("s_waitcnt vmcnt(0)" ::: "memory");
            const unsigned og = xb_add(&bar[XB_TOP], 1u);
            const unsigned tg = og / nx;
            if (og + 1u == (tg + 1u) * nx) xb_add(&bar[XB_TOPGEN], 1u);
            else XB_SPIN(xb_ld(&bar[XB_TOPGEN]) == tg, bar);
            __builtin_amdgcn_fence(__ATOMIC_ACQUIRE, "agent");
            xb_add(&bar[XB_XGEN(b.x)], 1u);
            asm volatile("s_waitcnt vmcnt(0)" ::: "memory");
        } else {
            XB_SPIN(xb_ld(&bar[XB_XGEN(b.x)]) == gen, bar);
            __builtin_amdgcn_fence(__ATOMIC_ACQUIRE, "agent");
            asm volatile("s_waitcnt vmcnt(0)" ::: "memory");
        }
    }
    __syncthreads();
}
typedef unsigned v4u __attribute__((ext_vector_type(4)));
typedef unsigned v2u __attribute__((ext_vector_type(2)));
typedef float f32x4 __attribute__((ext_vector_type(4)));
typedef float f32x2 __attribute__((ext_vector_type(2)));
__device__ __forceinline__ unsigned pk2(float lo, float hi) { unsigned r; asm volatile("v_cvt_pk_bf16_f32 %0, %1, %2" : "=v"(r) : "v"(lo), "v"(hi)); return r; }
__device__ __forceinline__ float bf_lo(unsigned w) { return __uint_as_float(w << 16); }
__device__ __forceinline__ float bf_hi(unsigned w) { return __uint_as_float(w & 0xffff0000u); }
__device__ __forceinline__ float wave_sum(float v) {
#pragma unroll
    for (int o = 1; o < 64; o <<= 1) v += __shfl_xor(v, o);
    return v;
}
struct Args { const float* in[21]; float* out; unsigned char* ws; int ph_lo, ph_hi; };
enum { I_X = 0, I_C, I_WADA, I_BADA, I_GNA, I_GNF, I_WQKVA, I_GQKA, I_WOA, I_WADAKV, I_BADAKV, I_GNKV, I_WKV, I_GKB, I_WF, I_BF, I_WQB, I_GQB, I_WOB, I_WFI, I_WFO };

constexpr int TSCR = 64 * 65 * 4;
__device__ __forceinline__ void transpose_item(const float* W, int K, int N, bf16* WT, int k0, int n0, int nd0, int kind, LAS float* scr, int lane) {
    const int lr = lane >> 4, lc = (lane & 15) * 4;
    f32x4 v[16];
    const float* wp = W + (size_t)(k0 + lr) * N + n0 + lc;
#pragma unroll
    for (int i = 0; i < 16; ++i) v[i] = *(const f32x4*)(wp + (size_t)(4 * i) * N);
#pragma unroll
    for (int i = 0; i < 16; ++i) { LAS float* d = scr + (4 * i + lr) * 65 + lc; d[0] = v[i].x; d[1] = v[i].y; d[2] = v[i].z; d[3] = v[i].w; }
    asm volatile("s_waitcnt lgkmcnt(0)" ::: "memory");
    const int c = lane & 7;
#pragma unroll
    for (int j = 0; j < 8; ++j) { const int n = (lane >> 3) + 8 * j; const LAS float* sp = scr + (8 * c) * 65 + n;
        v4u o; o.x = pk2(sp[0 * 65], sp[1 * 65]); o.y = pk2(sp[2 * 65], sp[3 * 65]); o.z = pk2(sp[4 * 65], sp[5 * 65]); o.w = pk2(sp[6 * 65], sp[7 * 65]);
        int nd = nd0 + n;
        if (kind == 2) { const int col = n0 + n, d = col & 127;
            if (col < 6144 && d < 32) nd = (col & ~31) + 8 * ((d & 15) >> 2) + 4 * (d >> 4) + (d & 3); }
        *(v4u*)(WT + (size_t)nd * K + k0 + 8 * c) = o; }
    asm volatile("s_waitcnt lgkmcnt(0)" ::: "memory");
}
__device__ __forceinline__ void transpose_matrix_items(const float* W, int K, int N, bf16* WT, int kind, int item, LAS float* scr, int lane) {
    const int nblk = N / 64, kb = item / nblk, nb = item % nblk, n0 = 64 * nb; int nd0 = n0;
    if (kind == 1) { const int half = n0 >= DFF, nn = n0 - half * DFF; nd0 = 256 * (nn >> 7) + 128 * half + (nn & 127); }
    transpose_item(W, K, N, WT, 64 * kb, n0, nd0, kind, scr, lane);
}
__device__ __forceinline__ void sincos_d(double a, double& s, double& c) {
    const double n = rint(a * 0.6366197723675814); const int q = (int)n & 3;
    double r = fma(-n, 1.5707963267948966, a); r = fma(-n, 6.123233995736766e-17, r);
    const double r2 = r * r;
    double sp = -7.647163731819816e-13; sp = fma(sp, r2, 1.6059043836821613e-10); sp = fma(sp, r2, -2.505210838544172e-08); sp = fma(sp, r2, 2.7557319223985893e-06);
    sp = fma(sp, r2, -1.984126984126984e-04); sp = fma(sp, r2, 8.333333333333333e-03); sp = fma(sp, r2, -1.6666666666666666e-01); sp = fma(sp * r2, r, r);
    double cp = 4.779477332387385e-14; cp = fma(cp, r2, -1.1470745597729725e-11); cp = fma(cp, r2, 2.08767569878681e-09); cp = fma(cp, r2, -2.755731922398589e-07);
    cp = fma(cp, r2, 2.48015873015873e-05); cp = fma(cp, r2, -1.388888888888889e-03); cp = fma(cp, r2, 4.1666666666666664e-02); cp = fma(cp, r2, -0.5); cp = fma(cp, r2, 1.0);
    s = (q == 0) ? sp : (q == 1) ? cp : (q == 2) ? -sp : -cp;
    c = (q == 0) ? cp : (q == 1) ? -sp : (q == 2) ? -cp : sp;
}
__device__ __forceinline__ float rope_inv(int i) {
    switch (i) { case 0: return 1.0f; case 1: return 0.44036659598350525f; case 2: return 0.1939227432012558f; case 3: return 0.08539710193872452f;
        case 4: return 0.03760603070259094f; case 5: return 0.01656043902039528f; case 6: return 0.007292664609849453f; case 7: return 0.0032114458736032248f;
        case 8: return 0.0014142135623842478f; case 9: return 0.000622772378847003f; case 10: return 0.00027424818836152554f; case 11: return 0.00012076973507646471f;
        case 12: return 5.318296098266728e-05f; case 13: return 2.34199997066753e-05f; case 14: return 1.0313386155758053e-05f; default: return 4.541670477919979e-06f; }
}
__device__ __forceinline__ void phase_prologue(const Args& a, LAS unsigned char* lds) {
    const int tid = threadIdx.x, lane = tid & 63, wave = __builtin_amdgcn_readfirstlane(tid >> 6), G = gridDim.x;
    unsigned char* ws = a.ws;
    for (int tk0 = blockIdx.x; tk0 < (MODS_LD / 128) * ((PROBE_DUP == 23) ? 1 + (a.ph_hi > 0) : 1); tk0 += G) { const int tk = tk0 % (MODS_LD / 128);
        LAS float* ct = (LAS float*)lds;
        for (int idx = tid; idx < BATCH * DM; idx += NWAVES * 64) { const int b = idx >> 11, k = idx & 2047; const float v = a.in[I_C][idx]; ct[k * 16 + b] = v / (1.f + __expf(-v)); }
        __syncthreads();
        const int col0 = tk * 128; const float* W; int pitch, wc0; const float* bias;
        if (col0 < 2 * 12288) { const int l = col0 / 12288; wc0 = col0 - l * 12288; W = a.in[I_WADA] + (size_t)l * DM * 12288; pitch = 12288; bias = a.in[I_BADA] + col0; }
        else { wc0 = col0 - 2 * 12288; W = a.in[I_WADAKV]; pitch = 4096; bias = a.in[I_BADAKV] + wc0; }
        float acc[16][2];
#pragma unroll
        for (int b = 0; b < 16; ++b) { acc[b][0] = 0.f; acc[b][1] = 0.f; }
        const float* wp = W + (size_t)(wave * 256) * pitch + wc0 + 2 * lane;
#pragma unroll 8
        for (int k = 0; k < 256; ++k) { const f32x2 wv = *(const f32x2*)(wp + (size_t)k * pitch); const LAS f32x4* cp = (const LAS f32x4*)(ct + (wave * 256 + k) * 16);
#pragma unroll
            for (int q = 0; q < 4; ++q) { const f32x4 cv = cp[q];
#pragma unroll
                for (int j = 0; j < 4; ++j) { acc[4 * q + j][0] = fmaf(cv[j], wv.x, acc[4 * q + j][0]); acc[4 * q + j][1] = fmaf(cv[j], wv.y, acc[4 * q + j][1]); } } }
        __syncthreads();
        LAS float* red = (LAS float*)lds;
#pragma unroll
        for (int b = 0; b < 16; ++b) { red[(wave * 16 + b) * 128 + 2 * lane] = acc[b][0]; red[(wave * 16 + b) * 128 + 2 * lane + 1] = acc[b][1]; }
        __syncthreads();
        float* mods = (float*)(ws + WS_MODS);
        for (int idx = tid; idx < 16 * 128; idx += NWAVES * 64) { const int b = idx >> 7, cc = idx & 127; float s = bias[cc];
#pragma unroll
            for (int w = 0; w < 8; ++w) s += red[(w * 16 + b) * 128 + cc];
            mods[(size_t)b * MODS_LD + col0 + cc] = s; }
        __syncthreads();
    }
    { float* rt = (float*)(ws + WS_ROPE);
      for (int idx = blockIdx.x * (NWAVES * 64) + tid; idx < SEQ * 16; idx += G * NWAVES * 64) { const int t = idx >> 4, i = idx & 15;
          const float ang = (float)t * rope_inv(i); double s, c; sincos_d((double)ang, s, c); rt[idx] = (float)c; rt[SEQ * 16 + idx] = (float)s; } }
    { bf16* wkv = (bf16*)(ws + WS_WKV) + (size_t)NKV * DM;
      for (int idx = blockIdx.x * (NWAVES * 64) + tid; idx < 256 * DM; idx += G * NWAVES * 64) { const int n = idx >> 11, k = idx & 2047;
          wkv[idx] = n < 16 ? (bf16)(pk2(a.in[I_WF][k * 16 + n], 0.f) & 0xffffu) : (bf16)0; } }
    { float* rss = (float*)(ws + WS_RSS); for (int idx = blockIdx.x * (NWAVES * 64) + tid; idx < 3 * M; idx += G * NWAVES * 64) rss[idx] = 0.f; }
    __syncthreads();
    LAS float* scr = (LAS float*)(lds + wave * TSCR);
    const int gw = blockIdx.x * NWAVES + wave, NGW = G * NWAVES;
    constexpr int I0 = (DM / 64) * (NQKV / 64), I1 = (WA / 64) * (DM / 64), I2 = (DM / 64) * (NKV / 64), I3 = (DM / 64) * (DM / 64), I5 = (DM / 64) * (NFFN / 64), I7 = (DFF / 64) * (DM / 64);
    constexpr int NIT = I0 + I1 + I2 + 2 * I3 + 2 * I5 + 2 * I7;
    for (int it = gw; it < NIT * ((PROBE_DUP == 24) ? 1 + (a.ph_hi > 0) : 1); it += NGW) {
        int r = it % NIT;
        if (r < I0) { transpose_matrix_items(a.in[I_WQKVA], DM, NQKV, (bf16*)(ws + WS_WQKV), 2, r, scr, lane); continue; } r -= I0;
        if (r < I1) { transpose_matrix_items(a.in[I_WOA], WA, DM, (bf16*)(ws + WS_WOA), 0, r, scr, lane); continue; } r -= I1;
        if (r < I2) { transpose_matrix_items(a.in[I_WKV], DM, NKV, (bf16*)(ws + WS_WKV), 0, r, scr, lane); continue; } r -= I2;
        if (r < I3) { transpose_matrix_items(a.in[I_WQB], DM, DM, (bf16*)(ws + WS_WQB), 0, r, scr, lane); continue; } r -= I3;
        if (r < I3) { transpose_matrix_items(a.in[I_WOB], DM, DM, (bf16*)(ws + WS_WOB), 0, r, scr, lane); continue; } r -= I3;
        if (r < 2 * I5) { const int l = r / I5; transpose_matrix_items(a.in[I_WFI] + (size_t)l * DM * NFFN, DM, NFFN, (bf16*)(ws + WS_WFI) + (size_t)l * NFFN * DM, 1, r - l * I5, scr, lane); continue; } r -= 2 * I5;
        { const int l = r / I7; transpose_matrix_items(a.in[I_WFO] + (size_t)l * DFF * DM, DFF, DM, (bf16*)(ws + WS_WFO) + (size_t)l * DM * DFF, 0, r - l * I7, scr, lane); }
    }
    __syncthreads();
}
template <bool DUAL>
__device__ __forceinline__ void phase_norm(const float* x, const float* g1, const float* sh1, const float* sc1, bf16* o1,
                                           const float* g2, const float* sh2, const float* sc2, bf16* o2) {
    const int lane = threadIdx.x & 63, wave = threadIdx.x >> 6; const int gw = blockIdx.x * NWAVES + wave, NGW = gridDim.x * NWAVES;
    f32x4 v[8];
    if (gw < M) { const f32x4* xr = (const f32x4*)(x + (size_t)gw * DM) + lane;
#pragma unroll
        for (int j = 0; j < 8; ++j) v[j] = xr[64 * j]; }
    for (int row = gw; row < M; row += NGW) {
        const int b = row >> 11; float s = 0.f;
        f32x4 nv[8]; const int nrow = row + NGW;
        if (nrow < M) { const f32x4* xr = (const f32x4*)(x + (size_t)nrow * DM) + lane;
#pragma unroll
            for (int j = 0; j < 8; ++j) nv[j] = xr[64 * j]; }
#pragma unroll
        for (int j = 0; j < 8; ++j) s += (v[j].x * v[j].x + v[j].y * v[j].y) + (v[j].z * v[j].z + v[j].w * v[j].w);
        const float rstd = 1.0f / sqrtf(wave_sum(s) * (1.f / DM) + EPS);
#pragma unroll
        for (int j = 0; j < 8; ++j) { const int col = 4 * lane + 256 * j;
            { const f32x4 gv = *(const f32x4*)(g1 + col), sh = *(const f32x4*)(sh1 + (size_t)b * MODS_LD + col), sc = *(const f32x4*)(sc1 + (size_t)b * MODS_LD + col);
              const f32x4 h = (v[j] * rstd * gv) * (sc + 1.f) + sh; v2u w; w.x = pk2(h.x, h.y); w.y = pk2(h.z, h.w); *(v2u*)(o1 + (size_t)row * DM + col) = w; }
            if (DUAL) { const f32x4 gv = *(const f32x4*)(g2 + col), sh = *(const f32x4*)(sh2 + (size_t)b * MODS_LD + col), sc = *(const f32x4*)(sc2 + (size_t)b * MODS_LD + col);
              const f32x4 h = (v[j] * rstd * gv) * (sc + 1.f) + sh; v2u w; w.x = pk2(h.x, h.y); w.y = pk2(h.z, h.w); *(v2u*)(o2 + (size_t)row * DM + col) = w; } }
#pragma unroll
        for (int j = 0; j < 8; ++j) v[j] = nv[j];
    }
}

__device__ __forceinline__ void phase_sw(const Args& a) {
    typedef short bf16x8_t __attribute__((ext_vector_type(8))); typedef float f32x16_t __attribute__((ext_vector_type(16)));
    const int lane = threadIdx.x & 63, wave = threadIdx.x >> 6; const int gw = blockIdx.x * NWAVES + wave, NGW = gridDim.x * NWAVES;
    unsigned char* ws = a.ws; const float* mods = (const float*)(ws + WS_MODS); float* SW = (float*)(ws + WS_SW);
    constexpr int T0 = NFFN / 32, T1 = NKVF / 32, T2 = DM / 32, NT = 2 * T0 + T1 + T2;
    const int m = lane & 31, kh = lane >> 5;
    for (int t = gw; t < NT; t += NGW) {
        const bf16* Bt; const float* sh; float* out; int nrows, r0;
        if (t < T0) { Bt = (const bf16*)(ws + WS_WFI); sh = mods + 6144; out = SW + SW_OFF0; nrows = NFFN; r0 = t * 32; }
        else if (t < T0 + T1) { Bt = (const bf16*)(ws + WS_WKV); sh = mods + 24576; out = SW + SW_OFF1; nrows = NKVF; r0 = (t - T0) * 32; }
        else if (t < T0 + T1 + T2) { Bt = (const bf16*)(ws + WS_WQB); sh = mods + 12288; out = SW + SW_OFF2; nrows = DM; r0 = (t - T0 - T1) * 32; }
        else { Bt = (const bf16*)(ws + WS_WFI) + (size_t)NFFN * DM; sh = mods + 12288 + 6144; out = SW + SW_OFF3; nrows = NFFN; r0 = (t - T0 - T1 - T2) * 32; }
        const bf16* ap = Bt + (size_t)(r0 + m) * DM + kh * 8; const float* bp = sh + (size_t)(m & 15) * MODS_LD + kh * 8;
        f32x16_t acc = {};
#pragma unroll 8
        for (int kk = 0; kk < DM / 16; ++kk) { const bf16x8_t av = *(const bf16x8_t*)(ap + kk * 16);
            const f32x4 b0 = *(const f32x4*)(bp + kk * 16), b1 = *(const f32x4*)(bp + kk * 16 + 4);
            v4u w; w.x = pk2(b0.x, b0.y); w.y = pk2(b0.z, b0.w); w.z = pk2(b1.x, b1.y); w.w = pk2(b1.z, b1.w);
            if (m >= 16) { w.x = 0; w.y = 0; w.z = 0; w.w = 0; }
            acc = __builtin_amdgcn_mfma_f32_32x32x16_bf16(av, __builtin_bit_cast(bf16x8_t, w), acc, 0, 0, 0); }
        if (m < 16) {
#pragma unroll
            for (int r = 0; r < 16; ++r) out[(size_t)m * nrows + r0 + (r & 3) + 8 * (r >> 2) + 4 * kh] = acc[r]; }
    }
}

__device__ __forceinline__ void phase_fgate(const bf16* Hm, const bf16* Wf, const float* rss, const float* swf, float* logf) {
    typedef short bf16x8_t __attribute__((ext_vector_type(8))); typedef float f32x16_t __attribute__((ext_vector_type(16)));
    const int lane = threadIdx.x & 63, wave = threadIdx.x >> 6; const int gw = blockIdx.x * NWAVES + wave, NGW = gridDim.x * NWAVES;
    const int m = lane & 31, kh = lane >> 5;
    for (int t = gw; t < M / 32; t += NGW) {
        const int r0 = t * 32;
        const bf16* ap = Hm + (size_t)(r0 + m) * DM + kh * 8; const bf16* bp = Wf + (size_t)m * DM + kh * 8;
        f32x16_t acc = {}, acc1 = {}, acc2 = {}, acc3 = {};
#pragma unroll 2
        for (int kk = 0; kk < DM / 16; kk += 4) {
            const bf16x8_t a0 = *(const bf16x8_t*)(ap + kk * 16), a1 = *(const bf16x8_t*)(ap + kk * 16 + 16), a2 = *(const bf16x8_t*)(ap + kk * 16 + 32), a3 = *(const bf16x8_t*)(ap + kk * 16 + 48);
            const bf16x8_t b0 = *(const bf16x8_t*)(bp + kk * 16), b1 = *(const bf16x8_t*)(bp + kk * 16 + 16), b2 = *(const bf16x8_t*)(bp + kk * 16 + 32), b3 = *(const bf16x8_t*)(bp + kk * 16 + 48);
            acc = __builtin_amdgcn_mfma_f32_32x32x16_bf16(a0, b0, acc, 0, 0, 0); acc1 = __builtin_amdgcn_mfma_f32_32x32x16_bf16(a1, b1, acc1, 0, 0, 0);
            acc2 = __builtin_amdgcn_mfma_f32_32x32x16_bf16(a2, b2, acc2, 0, 0, 0); acc3 = __builtin_amdgcn_mfma_f32_32x32x16_bf16(a3, b3, acc3, 0, 0, 0); }
        acc = (acc + acc1) + (acc2 + acc3);
        if (m < 16) { const int b = r0 >> 11; const float sv = swf[(size_t)b * NKVF + NKV + m]; float* op = logf + ((size_t)b * 16 + m) * SEQ + (r0 & (SEQ - 1));
#pragma unroll
            for (int r = 0; r < 16; ++r) { const int rr = (r & 3) + 8 * (r >> 2) + 4 * kh; op[rr] = acc[r] * __builtin_amdgcn_rsqf(rss[r0 + rr] * (1.f / DM) + EPS) + sv; } }
    }
}
template <bool ROPE>
__device__ __forceinline__ void phase_qknorm(bf16* buf, size_t pitch, int nchunk, const float* gains, int gshift, const float* rope, int dry = 0) {
    const int lane = threadIdx.x & 63, wave = threadIdx.x >> 6; const int gw = blockIdx.x * NWAVES + wave, NGW = gridDim.x * NWAVES;
    const int nq = nchunk >> 2, j = lane & 15; const long total = (long)M * nq;
    for (long it0 = gw; it0 < total; it0 += 4L * NGW) {
        v4u raw[4]; bf16* pp[4]; int ch[4], tok[4]; bool ok[4];
#pragma unroll
        for (int u = 0; u < 4; ++u) { const long it = it0 + (long)u * NGW; ok[u] = it < total; const long itc = ok[u] ? it : it0; tok[u] = (int)(itc / nq); ch[u] = (int)(itc % nq) * 4 + (lane >> 4);
            pp[u] = buf + (size_t)tok[u] * pitch + ch[u] * 128 + j * 8; raw[u] = *(const v4u*)pp[u]; }
#pragma unroll
        for (int u = 0; u < 4; ++u) {
            float x[8]; x[0] = bf_lo(raw[u].x); x[1] = bf_hi(raw[u].x); x[2] = bf_lo(raw[u].y); x[3] = bf_hi(raw[u].y); x[4] = bf_lo(raw[u].z); x[5] = bf_hi(raw[u].z); x[6] = bf_lo(raw[u].w); x[7] = bf_hi(raw[u].w);
            float ss = 0.f;
#pragma unroll
            for (int i = 0; i < 8; ++i) ss += x[i] * x[i];
            ss += __shfl_xor(ss, 1); ss += __shfl_xor(ss, 2); ss += __shfl_xor(ss, 4); ss += __shfl_xor(ss, 8);
            const float rstd = 1.0f / sqrtf(ss * (1.f / HD) + EPS);
            const float* gp = gains + (size_t)(ch[u] >> gshift) * HD + j * 8; const f32x4 g0 = *(const f32x4*)gp, g1 = *(const f32x4*)(gp + 4);
            float y[8];
#pragma unroll
            for (int i = 0; i < 4; ++i) { y[i] = x[i] * rstd * g0[i]; y[4 + i] = x[4 + i] * rstd * g1[i]; }
            if (ROPE) { const int pos = tok[u] & (SEQ - 1); const float* cp = rope + pos * 16 + (j & 1) * 8; const float* sp = cp + SEQ * 16;
#pragma unroll
                for (int i = 0; i < 8; ++i) { const float pv = __shfl_xor(y[i], 2); const float c = cp[i], s = sp[i];
                    const float r = (j < 2) ? (y[i] * c - pv * s) : (y[i] * c + pv * s); y[i] = (j < 4) ? r : y[i]; } }
            v4u w; w.x = pk2(y[0], y[1]); w.y = pk2(y[2], y[3]); w.z = pk2(y[4], y[5]); w.w = pk2(y[6], y[7]);
            if (ok[u] && !dry) *(v4u*)pp[u] = w;
        }
    }
}
__device__ __forceinline__ void phase_combine(const bf16* qkv, const float* lse, bf16* oc) {
    const int lane = threadIdx.x & 63, wave = threadIdx.x >> 6; const int gw = blockIdx.x * NWAVES + wave, NGW = gridDim.x * NWAVES;
    const int j = lane & 15; const long total = (long)M * 2;
    constexpr int UN = 4;
    for (long it0 = gw; it0 < total; it0 += (long)UN * NGW) {
        v4u raw[UN][3]; float l[UN][3]; int tok[UN], h[UN]; bool ok[UN];
#pragma unroll
        for (int u = 0; u < UN; ++u) { const long it = it0 + (long)u * NGW; ok[u] = it < total; const long itc = ok[u] ? it : it0; tok[u] = (int)(itc >> 1); h[u] = (int)(itc & 1) * 4 + (lane >> 4);
#pragma unroll
            for (int g = 0; g < 3; ++g) { raw[u][g] = *(const v4u*)(qkv + (size_t)tok[u] * NQKV + g * WA + h[u] * HD + j * 8); l[u][g] = lse[((size_t)g * M + tok[u]) * 8 + h[u]]; } }
#pragma unroll
        for (int u = 0; u < UN; ++u) {
            const float mx = fmaxf(l[u][0], fmaxf(l[u][1], l[u][2])); float e[3]; e[0] = __expf(l[u][0] - mx); e[1] = __expf(l[u][1] - mx); e[2] = __expf(l[u][2] - mx);
            const float inv = 1.f / (e[0] + e[1] + e[2]); float y[8];
#pragma unroll
            for (int i = 0; i < 8; ++i) y[i] = 0.f;
#pragma unroll
            for (int g = 0; g < 3; ++g) { const float al = e[g] * inv; const v4u r = raw[u][g];
                y[0] += al * bf_lo(r.x); y[1] += al * bf_hi(r.x); y[2] += al * bf_lo(r.y); y[3] += al * bf_hi(r.y);
                y[4] += al * bf_lo(r.z); y[5] += al * bf_hi(r.z); y[6] += al * bf_lo(r.w); y[7] += al * bf_hi(r.w); }
            v4u w; w.x = pk2(y[0], y[1]); w.y = pk2(y[2], y[3]); w.z = pk2(y[4], y[5]); w.w = pk2(y[6], y[7]);
            if (ok[u]) *(v4u*)(oc + (size_t)tok[u] * WA + h[u] * HD + j * 8) = w;
        }
    }
}
__device__ __forceinline__ void phase_scan(const float* logf, float* fb) {
    const int lane = threadIdx.x & 63, wave = threadIdx.x >> 6;
    if (wave != 0) return;
    for (int bh = blockIdx.x; bh < BATCH * 16; bh += gridDim.x) {
        const int b = bh >> 4, h = bh & 15; const float* p = logf + ((size_t)b * SEQ + lane * 32) * 16 + h;
        double tot = 0.0;
        for (int i = 0; i < 32; ++i) tot += (double)p[i * 16];
        double incl = tot;
#pragma unroll
        for (int o = 1; o < 64; o <<= 1) { const double t = __shfl_up(incl, o); if (lane >= o) incl += t; }
        double run = incl - tot;
        for (int i = 0; i < 32; ++i) { run += (double)p[i * 16]; fb[(size_t)bh * SEQ + lane * 32 + i] = (float)(-run * 11.313708498984761); }
    }
}
__device__ __forceinline__ void phase_attn_a(bf16* qkv, float* lse, LAS unsigned char* lds, int dry) {
    const int wid = __builtin_amdgcn_readfirstlane(threadIdx.x >> 6), half = wid >> 2;
    constexpr int NU = BATCH * 3 * 4 * 16;
    const int G_ = gridDim.x, bx_ = blockIdx.x; const int vcu_ = (G_ % 8 == 0) ? (bx_ % 8) * (G_ / 8) + bx_ / 8 : bx_;
    for (int u = vcu_; u < NU; u += G_) {
        const int g = u >> 10, rem = u & 1023, bhp = rem >> 4, idx = rem & 15, b = bhp >> 2, h = (bhp & 3) * 2 + half;
        int dil, res, qb;
        if (g == 0) { dil = 1; res = 0; qb = idx; } else if (g == 1) { dil = 4; res = idx & 3; qb = idx >> 2; } else { dil = 16; res = idx; qb = 0; }
        const size_t tok0 = (size_t)b * SEQ + res;
        att::Unit U;
        const bf16* base = qkv + tok0 * NQKV + h * HD;
        U.ldq = (long)NQKV * dil; U.ldk = U.ldq;
        U.Q = base + (size_t)g * WA + (size_t)(qb * 128) * U.ldq; U.O = (bf16*)U.Q;
        U.K = base + (size_t)(3 + g) * WA; U.V = base + (size_t)(6 + g) * WA;
        U.P0 = qb * 128; U.W = 129; U.j_lo = qb ? 2 * qb - 2 : 0; U.NT = qb ? 4 : 2;
        U.lse = lse + ((size_t)g * M + tok0 + (size_t)(qb * 128) * dil) * 8 + h; U.lse_ld = 8L * dil; U.dry = dry;
        att::attn_unit<false, false>(U, (ALAS char*)lds);
    }
}
__device__ __forceinline__ void phase_attn_b(bf16* qb_, const bf16* kv, const float* logf, const float* bfp, LAS unsigned char* lds, int dry) {
    const int G = gridDim.x, bx = blockIdx.x; const int vcu = (G % 8 == 0) ? (bx % 8) * (G / 8) + bx / 8 : bx;
    constexpr int NU = BATCH * 16 * 8;
    for (int u = (G == 256 ? 0 : bx); u < (G == 256 ? 8 : NU); u += (G == 256 ? 1 : G)) {
        int bh, qblk;
        if (G == 256) { const int j = vcu & 7, p = j & 3; bh = (vcu >> 3) * 8 + 2 * (u >> 1) + (j >> 2); qblk = (u & 1) ? 7 - p : p; }
        else { bh = u >> 3; qblk = u & 7; }
        const int b = bh >> 4, h = bh & 15;
        att::Unit U;
        U.ldq = DM; U.ldk = NKV;
        U.Q = qb_ + ((size_t)b * SEQ + qblk * 256) * DM + h * HD; U.O = (bf16*)U.Q;
        U.K = kv + (size_t)b * SEQ * NKV + h * HD; U.V = U.K + DM;
        U.P0 = qblk * 256; U.W = 1 << 30; U.j_lo = 0; U.NT = 4 * (qblk + 1);
        U.lse = nullptr; U.lse_ld = 0; U.dry = dry;
        { int tid = threadIdx.x; asm volatile("" : "+v"(tid));
          const int lane = tid & 63, wave = tid >> 6;
          const f32x4 zr = *(const f32x4*)(logf + (size_t)bh * SEQ + 4 * tid); const float bfv = bfp[h];
          float zv[4];
#pragma unroll
          for (int i = 0; i < 4; ++i) { const float z = zr[i] + bfv; zv[i] = fminf(z, 0.f) - __logf(1.f + __expf(-fabsf(z))); }
          const double s1 = (double)zv[0], s2 = s1 + (double)zv[1], s3 = s2 + (double)zv[2], s4 = s3 + (double)zv[3];
          double incl = s4;
#pragma unroll
          for (int o = 1; o < 64; o <<= 1) { const double t = __shfl_up(incl, o); if (lane >= o) incl += t; }
          LAS double* wt = (LAS double*)(lds + att::SCR_OFF);
          if (lane == 63) wt[wave] = incl;
          __syncthreads();
          double off = incl - s4;
          for (int w = 0; w < wave; ++w) off += wt[w];
          LAS float* fbl = (LAS float*)(lds + att::FB_OFF) + 4 * tid; const double c = -11.313708498984761;
          fbl[0] = (float)((off + s1) * c); fbl[1] = (float)((off + s2) * c); fbl[2] = (float)((off + s3) * c); fbl[3] = (float)((off + s4) * c);
          __syncthreads(); }
        att::attn_unit_pipe<true>(U, (ALAS char*)lds);
    }
}

using EpiQKV = pg8::EpiStore<true, false>; using EpiKVQ = pg8::EpiStore<false, true>;
using EpiR5 = pg8::EpiResid<1, false, true>; using EpiR7 = pg8::EpiResid<2, true, true>; using EpiR10 = pg8::EpiResid<1, true, true>; using EpiR12 = pg8::EpiResid<0, true, false>;
__global__ void __launch_bounds__(NWAVES * 64) yoco_fwd(Args a) {
    extern __shared__ __attribute__((aligned(16))) unsigned char lds_raw[];
    LAS unsigned char* lds = (LAS unsigned char*)lds_raw;
    cg::grid_group grid = cg::this_grid();
    volatile LAS unsigned* MISC = (volatile LAS unsigned*)(lds + LDS_BYTES - 64);
    if (threadIdx.x < 16) MISC[threadIdx.x] = 0u;
    __syncthreads();
    XcdBarrier xbar = xcd_barrier_post((unsigned*)a.ws, MISC + 8);
    if (a.ph_hi < 0) grid.sync();
    unsigned char* ws = a.ws; const int G = gridDim.x, bx = blockIdx.x;
    const int lo = a.ph_lo, hi = a.ph_hi;
    float* mods = (float*)(ws + WS_MODS); float* xo = a.out;
    bf16* H = (bf16*)(ws + WS_H); bf16* H2 = (bf16*)((unsigned char*)a.out + 128 * MiB); bf16* QKV = (bf16*)(ws + WS_BIG); bf16* ACT = (bf16*)(ws + WS_BIG);
    bf16* OC = (bf16*)a.out; bf16* QB = (bf16*)(ws + WS_QB); bf16* KV = (bf16*)(ws + WS_KV);
    bf16* XB = (bf16*)(ws + WS_XB);
    float* LSE = (float*)(ws + WS_LSE); float* LOGF = (float*)(ws + WS_LOGF); float* FB = (float*)(ws + WS_FB); const float* ROPE = (const float*)(ws + WS_ROPE);
#define IN(k) (lo <= (k) && (k) < hi)
#define SEAM(k) do { if (IN(k) && IN((k) + 1)) xcd_barrier(xbar); } while (0)
#define GEMM(EPI, Aptr, Bptr, N_, K_, E) GEMMR(EPI, Aptr, Bptr, N_, K_, E, 1)
#define GEMMR(EPI, Aptr, Bptr, N_, K_, E, R_) do { pg8::Gemm g_{(const pg8::bf16_t*)(Aptr), (const pg8::bf16_t*)(Bptr), M, (N_), (K_)}; pg8::StaticOrder S_; S_.init(M, (N_), G, bx); S_.rep = (R_); \
        pg8::gemm_phase<EPI, pg8::StaticOrder, true, true>(lds, g_, S_, E); } while (0)
#define NREP(k) ((PROBE_DUP == (k)) ? 1 + (a.ph_hi > 0) : 1)
    float* RSS = (float*)(ws + WS_RSS); const float* SW = (const float*)(ws + WS_SW);
    if (IN(0)) { phase_prologue(a, lds); } SEAM(0);
    if (IN(1)) { phase_norm<false>(a.in[I_X], a.in[I_GNA], mods + 0, mods + 2048, H, nullptr, nullptr, nullptr, nullptr); phase_sw(a); } SEAM(1);
    if (IN(2)) { EpiQKV E{QKV, NQKV, 1 << 30, nullptr, nullptr, 24, a.in[I_GQKA], 3, ROPE, nullptr, nullptr, 0}; GEMMR(EpiQKV, H, ws + WS_WQKV, NQKV, DM, E, NREP(30)); } SEAM(2);
    if (IN(3)) {
_Pragma("nounroll")
        for (int rep = 0; rep < NREP(40); ++rep) phase_attn_a(QKV, LSE, lds, rep + 1 < NREP(40)); } SEAM(3);
    if (IN(4)) { phase_combine(QKV, LSE, OC); } SEAM(4);
    if (IN(5)) { EpiR5 E{a.in[I_X], XB, DM, mods + 4096, MODS_LD, RSS, a.in[I_GNF], mods + 8192, H, nullptr, nullptr, nullptr}; GEMMR(EpiR5, OC, ws + WS_WOA, DM, WA, E, NREP(33)); } SEAM(5);
    if (IN(6)) { pg8::EpiSwiglu E{ACT, DFF, RSS, SW + SW_OFF0, NFFN}; GEMMR(pg8::EpiSwiglu, H, ws + WS_WFI, NFFN, DM, E, NREP(8)); } SEAM(6);
    if (IN(7)) { EpiR7 E{XB, XB, DM, mods + 10240, MODS_LD, RSS + M, a.in[I_GNKV], mods + 24576 + 2048, H, a.in[I_GNA] + DM, mods + 12288 + 2048, H2}; GEMMR(EpiR7, ACT, ws + WS_WFO, DM, DFF, E, NREP(31)); } SEAM(7);
    if (IN(8)) { { EpiKVQ E{KV, NKV, 1 << 30, nullptr, nullptr, 8, a.in[I_GKB], 31, nullptr, RSS + M, SW + SW_OFF1, NKVF}; GEMMR(EpiKVQ, H, ws + WS_WKV, NKV, DM, E, NREP(32)); }
                 { EpiKVQ E{QB, DM, 1 << 30, nullptr, nullptr, 8, a.in[I_GQB], 31, nullptr, RSS + M, SW + SW_OFF2, DM}; GEMMR(EpiKVQ, H2, ws + WS_WQB, DM, DM, E, NREP(32)); }
                 phase_fgate(H, (const bf16*)(ws + WS_WKV) + (size_t)NKV * DM, RSS + M, SW + SW_OFF1, LOGF); } SEAM(8);
    if (IN(9)) {
_Pragma("nounroll")
        for (int rep = 0; rep < NREP(41); ++rep) phase_attn_b(QB, KV, LOGF, a.in[I_BF], lds, rep + 1 < NREP(41)); } SEAM(9);
    if (IN(10)) { EpiR10 E{XB, XB, DM, mods + 12288 + 4096, MODS_LD, RSS + 2 * M, a.in[I_GNF] + DM, mods + 12288 + 8192, H, nullptr, nullptr, nullptr}; GEMMR(EpiR10, QB, ws + WS_WOB, DM, DM, E, NREP(33)); } SEAM(10);
    if (IN(11)) { pg8::EpiSwiglu E{ACT, DFF, RSS + 2 * M, SW + SW_OFF3, NFFN}; GEMM(pg8::EpiSwiglu, H, (bf16*)(ws + WS_WFI) + (size_t)NFFN * DM, NFFN, DM, E); } SEAM(11);
    if (IN(12)) { EpiR12 E{XB, xo, DM, mods + 12288 + 10240, MODS_LD, nullptr, nullptr, nullptr, nullptr, nullptr, nullptr, nullptr}; GEMMR(EpiR12, ACT, (bf16*)(ws + WS_WFO) + (size_t)DM * DFF, DM, DFF, E, NREP(31)); }
#undef IN
#undef SEAM
#undef GEMM
#undef GEMMR
}

extern "C" void kernel_launch(void* const* d_in, const int* in_sizes, int n_in, void* d_out, int out_size, void* d_ws, size_t ws_size, hipStream_t stream) {
    static int grid = 0;
    if (grid == 0) {
        if (n_in != 21 || in_sizes[0] != M * DM || out_size != M * DM || ws_size < WS_END) { fprintf(stderr, "kernel_launch: unexpected shapes (n_in %d, in0 %d, out %d, ws %zu)\n", n_in, n_in > 0 ? in_sizes[0] : -1, out_size, ws_size); grid = -1; return; }
        int dev = 0, cus = 0, per_cu = 0;
        (void)hipGetDevice(&dev); (void)hipDeviceGetAttribute(&cus, hipDeviceAttributeMultiprocessorCount, dev);
        if (hipFuncSetAttribute((const void*)yoco_fwd, hipFuncAttributeMaxDynamicSharedMemorySize, LDS_BYTES) != hipSuccess) { fprintf(stderr, "kernel_launch: hipFuncSetAttribute failed\n"); grid = -1; return; }
        if (hipOccupancyMaxActiveBlocksPerMultiprocessor(&per_cu, (const void*)yoco_fwd, NWAVES * 64, LDS_BYTES) != hipSuccess || per_cu < 1) { fprintf(stderr, "kernel_launch: occupancy query says %d\n", per_cu); per_cu = 1; }
        (void)hipGetLastError();
        grid = cus > 0 ? cus : 256;
    }
    if (grid < 0) return;
    if (hipMemsetAsync(d_ws, 0, 16384, stream) != hipSuccess) { fprintf(stderr, "kernel_launch: memset failed\n"); return; }
    Args a{};
    for (int i = 0; i < 21; ++i) a.in[i] = (const float*)d_in[i];
    a.out = (float*)d_out; a.ws = (unsigned char*)d_ws;
#if MK_N_LAUNCHES == 1
    a.ph_lo = 0; a.ph_hi = NPHASE;
    void* args[] = {&a};
    hipError_t e = hipLaunchCooperativeKernel((const void*)yoco_fwd, dim3(grid), dim3(NWAVES * 64), args, LDS_BYTES, stream);
    if (e != hipSuccess) fprintf(stderr, "kernel_launch: cooperative launch failed: %s (grid %d)\n", hipGetErrorString(e), grid);
#else
    for (int p = 0; p < NPHASE; ++p) { a.ph_lo = p; a.ph_hi = p + 1; hipLaunchKernelGGL(yoco_fwd, dim3(grid), dim3(NWAVES * 64), LDS_BYTES, stream, a); }
#endif
}
```

```cpp
#include <hip/hip_runtime.h>
#include <hip/hip_cooperative_groups.h>
#include <cstdio>
#include <cstdint>
namespace cg = cooperative_groups;
namespace pg8 {
#define PG8_LAS __attribute__((address_space(3)))
typedef unsigned short bf16_t;
typedef short bf16x8 __attribute__((ext_vector_type(8)));
typedef float f32x4 __attribute__((ext_vector_type(4)));
typedef unsigned u32x4 __attribute__((ext_vector_type(4)));
constexpr int BM = 256, BK = 64, HALF = 128, HTB = HALF * BK * 2  , STAGE_BYTES = 8 * HTB, NXCD = 8, WGM = 4;

__host__ __device__ __forceinline__ int lds_byte(int r, int c) { const int st = (r >> 4) * 2 + (c >> 5), rr = r & 15, cc = c & 31, ob = rr * 64 + cc * 2; return st * 1024 + (ob ^ (((ob >> 9) & 1) << 5)); }
__host__ __device__ __forceinline__ void stage_rc(int b, int& R, int& C) { const int st = b / 1024, sb = b % 1024, swz = sb ^ (((sb >> 9) & 1) << 5); R = (st >> 1) * 16 + swz / 64; C = (st & 1) * 32 + (swz % 64) / 2; }
__host__ __device__ __forceinline__ int perm32(int rho) { const int n = rho >> 4, i = rho & 15; return 8 * (i >> 2) + 4 * n + (i & 3); }

struct Unit { int pm, pn, dry; };
struct Gemm { const bf16_t* A; const bf16_t* Bt; int M, N, K; };

struct StaticOrder {
    int nM, nN, nwg, G, c, rep;
    __host__ __device__ void init(int M, int N, int G_, int c_) { nM = M / BM; nN = N / BM; nwg = nM * nN; G = G_; c = c_; rep = 1; }
    __host__ __device__ bool next(int i, Unit& u) const {
        long L = (long)i * G + c; if (L >= (long)nwg * rep) return false; u.dry = 0; if (L >= nwg) { L -= nwg; u.dry = 1; }
        int wgid = (int)L; { const int q = nwg / NXCD, r = nwg % NXCD, xcd = wgid % NXCD, off = wgid / NXCD; wgid = (xcd < r ? xcd * (q + 1) : r * (q + 1) + (xcd - r) * q) + off; }
        const int nig = WGM * nN, gid = wgid / nig, fm = gid * WGM, gsz = (nM - fm) < WGM ? (nM - fm) : WGM;
        u.pm = fm + ((wgid % nig) % gsz); u.pn = (wgid % nig) / gsz; return true;
    }
    __device__ __forceinline__ void a_ready(const Unit&) const {}
    __device__ __forceinline__ void done(const Unit&) const {}
};

__device__ __forceinline__ unsigned cvt_pk_bf16(float lo, float hi) { unsigned r; asm volatile("v_cvt_pk_bf16_f32 %0, %1, %2" : "=v"(r) : "v"(lo), "v"(hi)); return r; }
template <bool ROPE, bool FUSED>
struct EpiStore {
    static constexpr bool PERM = true, AFTER_DRAIN = false;
    bf16_t* O; int ldc; int ftile; float* logf; const float* bf; int norm_tiles; const float* gains; int gsh; const float* rope; const float* rowss; const float* sw; int swpitch;
    __device__ __forceinline__ void operator()(const f32x4 (&acc_in)[2][2][4][2], const Unit& u, int wr, int wc, int fr_in, int fq_in, PG8_LAS unsigned char* lds) const {
        int fr = fr_in, fq = fq_in; asm volatile("" : "+v"(fr), "+v"(fq));
        const int row0 = u.pm * BM + wr * 64 + fr;
        float rstd[2][4]; f32x4 sv[2][2];
        if constexpr (FUSED) { const float* sp = sw + (size_t)(u.pm >> 3) * swpitch + u.pn * BM + wc * 32 + 8 * fq;
#pragma unroll
            for (int bj = 0; bj < 2; ++bj)
#pragma unroll
                for (int n = 0; n < 2; ++n) sv[bj][n] = *(const f32x4*)(sp + bj * HALF + 4 * n);
#pragma unroll
            for (int ai = 0; ai < 2; ++ai)
#pragma unroll
                for (int m = 0; m < 4; ++m) rstd[ai][m] = __builtin_amdgcn_rsqf(rowss[row0 + ai * HALF + m * 16] * (1.f / 2048.f) + 1e-6f);
        } else {
#pragma unroll
            for (int bj = 0; bj < 2; ++bj)
#pragma unroll
                for (int n = 0; n < 2; ++n) sv[bj][n] = (f32x4){0.f, 0.f, 0.f, 0.f};
#pragma unroll
            for (int ai = 0; ai < 2; ++ai)
#pragma unroll
                for (int m = 0; m < 4; ++m) rstd[ai][m] = 1.f;
        }
#define ACCV(ai, bj, m, n) (FUSED ? (acc_in[ai][bj][m][n] * rstd[ai][m] + sv[bj][n]) : acc_in[ai][bj][m][n])
        if (FUSED && u.pn >= ftile) {
            if (wc == 0 && fq < 2) {
#pragma unroll
                for (int ai = 0; ai < 2; ++ai)
#pragma unroll
                    for (int m = 0; m < 4; ++m) { const int row = row0 + ai * HALF + m * 16; float* rp = logf + ((size_t)(row >> 11) * 16 + 8 * fq) * 2048 + (row & 2047);
#pragma unroll
                        for (int n = 0; n < 2; ++n) { const f32x4 z = ACCV(ai, 0, m, n);
#pragma unroll
                            for (int j = 0; j < 4; ++j) rp[(size_t)(4 * n + j) * 2048] = z[j]; } }
            }
            return;
        }
        const bool nrm = u.pn < norm_tiles;
        float rs[2][4][2]; f32x4 gv[2][2];
        if (nrm) {
            PG8_LAS float* P = (PG8_LAS float*)(lds + STAGE_BYTES);
#pragma unroll
            for (int ai = 0; ai < 2; ++ai)
#pragma unroll
                for (int m = 0; m < 4; ++m)
#pragma unroll
                    for (int bj = 0; bj < 2; ++bj) { const f32x4 x0 = ACCV(ai, bj, m, 0), x1 = ACCV(ai, bj, m, 1);
                        float q = (x0[0] * x0[0] + x0[1] * x0[1]) + (x0[2] * x0[2] + x0[3] * x0[3]) + (x1[0] * x1[0] + x1[1] * x1[1]) + (x1[2] * x1[2] + x1[3] * x1[3]);
                        q += __shfl_xor(q, 16); q += __shfl_xor(q, 32);
                        if (fq == 0) P[((ai * HALF + wr * 64 + m * 16 + fr) * 2 + bj) * 4 + wc] = q; }
            asm volatile("s_waitcnt lgkmcnt(0)\n\ts_barrier" ::: "memory");
#pragma unroll
            for (int ai = 0; ai < 2; ++ai)
#pragma unroll
                for (int m = 0; m < 4; ++m)
#pragma unroll
                    for (int bj = 0; bj < 2; ++bj) { const f32x4 p = *(const PG8_LAS f32x4*)(P + ((ai * HALF + wr * 64 + m * 16 + fr) * 2 + bj) * 4);
                        rs[ai][m][bj] = __builtin_amdgcn_rsqf(((p[0] + p[1]) + (p[2] + p[3])) * (1.f / 128.f) + 1e-6f); }
#pragma unroll
            for (int bj = 0; bj < 2; ++bj) { const float* gp = gains + (size_t)((2 * u.pn + bj) >> gsh) * 128;
                if (ROPE && wc == 0) { gv[bj][0] = *(const f32x4*)(gp + 4 * fq); gv[bj][1] = *(const f32x4*)(gp + 4 * fq + 16); }
                else { gv[bj][0] = *(const f32x4*)(gp + wc * 32 + 8 * fq); gv[bj][1] = *(const f32x4*)(gp + wc * 32 + 8 * fq + 4); } }
        }
        const bool rp_on = ROPE && nrm && wc == 0;
        const int col0 = u.pn * BM + wc * 32 + 8 * fq;
#pragma unroll
        for (int ai = 0; ai < 2; ++ai) {
            f32x4 cs[4][2];
            if (rp_on) {
#pragma unroll
                for (int m = 0; m < 4; ++m) { const float* cp = rope + (size_t)((row0 + ai * HALF + m * 16) & 2047) * 16 + 4 * fq; cs[m][0] = *(const f32x4*)cp; cs[m][1] = *(const f32x4*)(cp + 2048 * 16); }
                asm volatile("" ::: "memory"); }
#pragma unroll
            for (int m = 0; m < 4; ++m) { const int row = row0 + ai * HALF + m * 16; bf16_t* rowp = O + (size_t)row * ldc + col0;
#pragma unroll
                for (int bj = 0; bj < 2; ++bj) { f32x4 v0 = ACCV(ai, bj, m, 0), v1 = ACCV(ai, bj, m, 1);
                    if (nrm) { v0 = v0 * rs[ai][m][bj] * gv[bj][0]; v1 = v1 * rs[ai][m][bj] * gv[bj][1]; }
                    if (rp_on) { const f32x4 x1 = v0, x2 = v1; v0 = x1 * cs[m][0] - x2 * cs[m][1]; v1 = x2 * cs[m][0] + x1 * cs[m][1]; }
                    u32x4 w; w.x = cvt_pk_bf16(v0[0], v0[1]); w.y = cvt_pk_bf16(v0[2], v0[3]); w.z = cvt_pk_bf16(v1[0], v1[1]); w.w = cvt_pk_bf16(v1[2], v1[3]);
                    *(u32x4*)(rowp + bj * HALF) = w; } }
        }
    }
#undef ACCV
};
struct EpiSwiglu {
    static constexpr bool PERM = true, AFTER_DRAIN = false;
    bf16_t* O; int ldc; const float* rowss; const float* sw; int swpitch;
    __device__ __forceinline__ void operator()(const f32x4 (&acc)[2][2][4][2], const Unit& u, int wr, int wc, int fr_in, int fq_in, PG8_LAS unsigned char* lds) const {
        int fr = fr_in, fq = fq_in; asm volatile("" : "+v"(fr), "+v"(fq));
        const int row0 = u.pm * BM + wr * 64 + fr, col0 = u.pn * HALF + wc * 32 + 8 * fq;
        f32x4 sv[2][2];
        { const float* sp = sw + (size_t)(u.pm >> 3) * swpitch + u.pn * BM + wc * 32 + 8 * fq;
#pragma unroll
          for (int bj = 0; bj < 2; ++bj)
#pragma unroll
              for (int n = 0; n < 2; ++n) sv[bj][n] = *(const f32x4*)(sp + bj * HALF + 4 * n); }
        float rsd[2][4];
#pragma unroll
        for (int ai = 0; ai < 2; ++ai)
#pragma unroll
            for (int m = 0; m < 4; ++m) rsd[ai][m] = rowss[row0 + ai * HALF + m * 16];
        asm volatile("" ::: "memory");
#pragma unroll
        for (int ai = 0; ai < 2; ++ai)
#pragma unroll
            for (int m = 0; m < 4; ++m) { const int row = row0 + ai * HALF + m * 16; bf16_t* rowp = O + (size_t)row * ldc + col0; float r[8];
                const float rstd = __builtin_amdgcn_rsqf(rsd[ai][m] * (1.f / 2048.f) + 1e-6f);
#pragma unroll
                for (int n = 0; n < 2; ++n)
#pragma unroll
                    for (int j = 0; j < 4; ++j) { const float g = fmaf(acc[ai][0][m][n][j], rstd, sv[0][n][j]), up = fmaf(acc[ai][1][m][n][j], rstd, sv[1][n][j]);
                        r[4 * n + j] = g * __builtin_amdgcn_rcpf(1.f + __builtin_amdgcn_exp2f(-1.4426950408889634f * g)) * up; }
                u32x4 w; w.x = cvt_pk_bf16(r[0], r[1]); w.y = cvt_pk_bf16(r[2], r[3]); w.z = cvt_pk_bf16(r[4], r[5]); w.w = cvt_pk_bf16(r[6], r[7]);
                *(u32x4*)rowp = w; }
    }
};
template <int NH, bool BIN, bool BOUT>
struct EpiResid {
    static constexpr bool PERM = true, AFTER_DRAIN = false, PREFETCH = false;
    const void* base; void* out; int ldc; const float* gate; int gpitch;
    float* rowss; const float* g1; const float* sc1; bf16_t* h1; const float* g2; const float* sc2; bf16_t* h2;
    __device__ __forceinline__ void operator()(const f32x4 (&acc)[2][2][4][2], const Unit& u, int wr, int wc, int fr_in, int fq_in, PG8_LAS unsigned char* lds) const {
        int fr = fr_in, fq = fq_in; asm volatile("" : "+v"(fr), "+v"(fq));
        const int row0 = u.pm * BM + wr * 64 + fr, col0 = u.pn * BM + wc * 32 + 8 * fq;
        const size_t boff = (size_t)(u.pm >> 3) * gpitch + col0;
        f32x4 gv[2][2], s1[2][2], s2[2][2];
#pragma unroll
        for (int bj = 0; bj < 2; ++bj)
#pragma unroll
            for (int n = 0; n < 2; ++n) { const int co = bj * HALF + 4 * n; gv[bj][n] = *(const f32x4*)(gate + boff + co);
                if (NH >= 1) s1[bj][n] = *(const f32x4*)(g1 + col0 + co) * (*(const f32x4*)(sc1 + boff + co) + 1.f);
                if (NH >= 2) s2[bj][n] = *(const f32x4*)(g2 + col0 + co) * (*(const f32x4*)(sc2 + boff + co) + 1.f); }
        constexpr int MB = (NH == 2) ? 2 : (BIN ? 4 : ((NH >= 1) ? 2 : 4));
#pragma unroll
        for (int am = 0; am < 8; am += MB) { const int ai = am >> 2;
            f32x4 bsv[MB][2][BIN ? 1 : 2];
#pragma unroll
            for (int mm = 0; mm < MB; ++mm) { const size_t off = (size_t)(row0 + ai * HALF + ((am & 3) + mm) * 16) * ldc + col0;
#pragma unroll
                for (int bj = 0; bj < 2; ++bj) {
                    if (BIN) bsv[mm][bj][0] = *(const f32x4*)((const bf16_t*)base + off + bj * HALF);
                    else {
#pragma unroll
                        for (int n = 0; n < (BIN ? 1 : 2); ++n) bsv[mm][bj][n] = *(const f32x4*)((const float*)base + off + bj * HALF + 4 * n); } } }
            asm volatile("" ::: "memory");
#pragma unroll
            for (int mm = 0; mm < MB; ++mm) { const int m = (am & 3) + mm; const int row = row0 + ai * HALF + m * 16; const size_t off = (size_t)row * ldc + col0; float q = 0.f;
#pragma unroll
                for (int bj = 0; bj < 2; ++bj) { f32x4 x[2];
                    if (BIN) { const u32x4 r = __builtin_bit_cast(u32x4, bsv[mm][bj][0]);
                        x[0] = (f32x4){__uint_as_float(r.x << 16), __uint_as_float(r.x & 0xffff0000u), __uint_as_float(r.y << 16), __uint_as_float(r.y & 0xffff0000u)};
                        x[1] = (f32x4){__uint_as_float(r.z << 16), __uint_as_float(r.z & 0xffff0000u), __uint_as_float(r.w << 16), __uint_as_float(r.w & 0xffff0000u)}; }
                    else { x[0] = bsv[mm][bj][0]; x[1] = bsv[mm][bj][BIN ? 0 : 1]; }
#pragma unroll
                    for (int n = 0; n < 2; ++n) { x[n] = x[n] + gv[bj][n] * acc[ai][bj][m][n];
                        q += (x[n][0] * x[n][0] + x[n][1] * x[n][1]) + (x[n][2] * x[n][2] + x[n][3] * x[n][3]); }
                    if (!u.dry) {
                        if (BOUT) { u32x4 w; w.x = cvt_pk_bf16(x[0][0], x[0][1]); w.y = cvt_pk_bf16(x[0][2], x[0][3]); w.z = cvt_pk_bf16(x[1][0], x[1][1]); w.w = cvt_pk_bf16(x[1][2], x[1][3]);
                            *(u32x4*)((bf16_t*)out + off + bj * HALF) = w; }
                        else { *(f32x4*)((float*)out + off + bj * HALF) = x[0]; *(f32x4*)((float*)out + off + bj * HALF + 4) = x[1]; } }
                    if (NH >= 1) { const f32x4 a0 = x[0] * s1[bj][0], a1 = x[1] * s1[bj][1]; u32x4 w; w.x = cvt_pk_bf16(a0[0], a0[1]); w.y = cvt_pk_bf16(a0[2], a0[3]); w.z = cvt_pk_bf16(a1[0], a1[1]); w.w = cvt_pk_bf16(a1[2], a1[3]);
                        if (!u.dry) *(u32x4*)(h1 + off + bj * HALF) = w; }
                    if (NH >= 2) { const f32x4 a0 = x[0] * s2[bj][0], a1 = x[1] * s2[bj][1]; u32x4 w; w.x = cvt_pk_bf16(a0[0], a0[1]); w.y = cvt_pk_bf16(a0[2], a0[3]); w.z = cvt_pk_bf16(a1[0], a1[1]); w.w = cvt_pk_bf16(a1[2], a1[3]);
                        if (!u.dry) *(u32x4*)(h2 + off + bj * HALF) = w; } }
                if (NH >= 1) { q += __shfl_xor(q, 16); q += __shfl_xor(q, 32); if (fq == 0 && !u.dry) __hip_atomic_fetch_add(rowss + row, q, __ATOMIC_RELAXED, __HIP_MEMORY_SCOPE_AGENT); } }
            asm volatile("" ::: "memory");
        }
    }
};
template <class Epi, class Sched, bool ALIGN_EPI = false, bool SP2 = false>
__device__ __forceinline__ void gemm_phase(PG8_LAS unsigned char* lds, const Gemm g, const Sched& S, const Epi& E) {
    const int tid = threadIdx.x, wid = __builtin_amdgcn_readfirstlane(tid >> 6), lane = tid & 63, wr = wid >> 2, wc = wid & 3, fr = lane & 15, fq = lane >> 4;
    const int K = g.K, nt = K / BK;
    unsigned voffA[2], voffB[2];
#pragma unroll
    for (int i = 0; i < 2; ++i) { int R, C; stage_rc(tid * 16 + i * 8192, R, C); const int Rb = Epi::PERM ? ((R & ~31) + perm32(R & 31)) : R;
        voffA[i] = (unsigned)(R * K + C) * 2u; voffB[i] = (unsigned)(Rb * K + C) * 2u; }
    const size_t kstep = (size_t)(BK * 2);
    const size_t hstep = (size_t)HALF * K * 2;
    const size_t tstep = 2 * hstep;
    const unsigned ldsw = (unsigned)wid * 1024u;
    const int aoff = lds_byte(wr * 64 + fr, fq * 8), boff = lds_byte(wc * 32 + fr, fq * 8);
#define PG8_SA(b, h) (((b) * 2 + (h)) * HTB)
#define PG8_SB(b, h) ((4 + (b) * 2 + (h)) * HTB)
#define PG8_STAGE(bufoff, gbase, voff) do { _Pragma("unroll") for (int _i = 0; _i < 2; ++_i) \
        __builtin_amdgcn_global_load_lds((const unsigned*)((const char*)(gbase) + (voff)[_i]), (PG8_LAS unsigned*)(lds + (bufoff) + ldsw + _i * 8192), 16, 0, 0); } while (0)
#define PG8_LDA(dst, b, h) do { _Pragma("unroll") for (int m = 0; m < 4; ++m) _Pragma("unroll") for (int k = 0; k < 2; ++k) dst[m][k] = *(const PG8_LAS bf16x8*)(lds + PG8_SA(b, h) + aoff + m * 2048 + k * 1024); } while (0)
#define PG8_LDB(dst, b, h) do { _Pragma("unroll") for (int n = 0; n < 2; ++n) _Pragma("unroll") for (int k = 0; k < 2; ++k) dst[n][k] = *(const PG8_LAS bf16x8*)(lds + PG8_SB(b, h) + boff + n * 2048 + k * 1024); } while (0)
#define PG8_MMA(ai, bj, At, Bt) do { __builtin_amdgcn_s_setprio(1); _Pragma("unroll") for (int m = 0; m < 4; ++m) _Pragma("unroll") for (int n = 0; n < 2; ++n) _Pragma("unroll") for (int k = 0; k < 2; ++k) \
        acc[ai][bj][m][n] = __builtin_amdgcn_mfma_f32_16x16x32_bf16(Bt[n][k], At[m][k], acc[ai][bj][m][n], 0, 0, 0); __builtin_amdgcn_s_setprio(0); } while (0)
#define PG8_WAIT_V(n) asm volatile("s_waitcnt vmcnt(" #n ")" ::: "memory")
#define PG8_WAIT_L(n) asm volatile("s_waitcnt lgkmcnt(" #n ")" ::: "memory")
#define PG8_BAR __builtin_amdgcn_s_barrier()
#define PG8_SCHED __builtin_amdgcn_sched_barrier(0)
    Unit cur, nxt; int ui = 0;
    if (!S.next(0, cur)) return;
    f32x4 acc[2][2][4][2];
#pragma unroll
    for (int a = 0; a < 2; ++a)
#pragma unroll
        for (int b = 0; b < 2; ++b)
#pragma unroll
            for (int m = 0; m < 4; ++m)
#pragma unroll
                for (int n = 0; n < 2; ++n) acc[a][b][m][n] = (f32x4){0.f, 0.f, 0.f, 0.f};
    bf16x8 At[4][2], B0[2][2], B1[2][2];
    const char* cA = (const char*)g.A + (size_t)cur.pm * tstep; const char* cB = (const char*)g.Bt + (size_t)cur.pn * tstep;
    S.a_ready(cur);
    if constexpr (SP2) {
        PG8_STAGE(PG8_SB(0, 0), cB, voffB); PG8_STAGE(PG8_SB(0, 1), cB + hstep, voffB); PG8_STAGE(PG8_SA(0, 0), cA, voffA); PG8_STAGE(PG8_SA(0, 1), cA + hstep, voffA);
        if (wr == 1) PG8_BAR;
        PG8_WAIT_V(2); PG8_BAR;
        PG8_STAGE(PG8_SB(1, 0), cB + kstep, voffB); PG8_STAGE(PG8_SA(1, 0), cA + kstep, voffA); PG8_STAGE(PG8_SB(1, 1), cB + hstep + kstep, voffB);
        PG8_WAIT_V(6); PG8_BAR;
    } else {
        PG8_STAGE(PG8_SB(0, 0), cB, voffB); PG8_STAGE(PG8_SA(0, 0), cA, voffA); PG8_STAGE(PG8_SB(0, 1), cB + hstep, voffB); PG8_STAGE(PG8_SA(0, 1), cA + hstep, voffA);
        if (wr == 1) PG8_BAR;
        PG8_WAIT_V(4); PG8_BAR;
        PG8_STAGE(PG8_SB(1, 0), cB + kstep, voffB); PG8_STAGE(PG8_SA(1, 0), cA + kstep, voffA); PG8_STAGE(PG8_SB(1, 1), cB + hstep + kstep, voffB);
        PG8_WAIT_V(6); PG8_BAR;
    }
    for (;;) {
        const bool has_next = S.next(ui + 1, nxt);
        const char* nA = has_next ? (const char*)g.A + (size_t)nxt.pm * tstep : cA; const char* nB = has_next ? (const char*)g.Bt + (size_t)nxt.pn * tstep : cB;
        for (int t = 0; t < nt; t += 2) {
            const bool last = (t == nt - 2);
            const char* a1 = cA + (size_t)(t + 1) * kstep;
            const char* a2 = last ? nA : cA + (size_t)(t + 2) * kstep; const char* b2 = last ? nB : cB + (size_t)(t + 2) * kstep;
            const char* a3 = a2 + kstep; const char* b3 = b2 + kstep;
            if (last && has_next) S.a_ready(nxt);
            if constexpr (SP2) {
            PG8_LDB(B0, 0, 0); PG8_LDB(B1, 0, 1); PG8_SCHED; PG8_LDA(At, 0, 0); PG8_STAGE(PG8_SA(1, 1), a1 + hstep, voffA);
            PG8_WAIT_V(8); PG8_WAIT_L(0); PG8_BAR; PG8_MMA(0, 0, At, B0); PG8_MMA(0, 1, At, B1); PG8_BAR; PG8_SCHED;
            PG8_LDA(At, 0, 1); PG8_STAGE(PG8_SB(0, 0), b2, voffB); PG8_STAGE(PG8_SB(0, 1), b2 + hstep, voffB); PG8_STAGE(PG8_SA(0, 0), a2, voffA);
            PG8_WAIT_V(8); PG8_WAIT_L(0); PG8_BAR; PG8_MMA(1, 0, At, B0); PG8_MMA(1, 1, At, B1); PG8_BAR; PG8_SCHED;
            PG8_LDB(B0, 1, 0); PG8_LDB(B1, 1, 1); PG8_SCHED; PG8_LDA(At, 1, 0); PG8_STAGE(PG8_SA(0, 1), a2 + hstep, voffA);
            PG8_WAIT_V(8); PG8_WAIT_L(0); PG8_BAR; PG8_MMA(0, 0, At, B0); PG8_MMA(0, 1, At, B1); PG8_BAR; PG8_SCHED;
            PG8_LDA(At, 1, 1); PG8_STAGE(PG8_SB(1, 0), b3, voffB); PG8_STAGE(PG8_SB(1, 1), b3 + hstep, voffB); PG8_STAGE(PG8_SA(1, 0), a3, voffA);
            PG8_WAIT_V(8); PG8_WAIT_L(0); PG8_BAR; PG8_MMA(1, 0, At, B0); PG8_MMA(1, 1, At, B1); PG8_BAR; PG8_SCHED;
            } else {
            PG8_LDB(B0, 0, 0); PG8_SCHED; PG8_LDA(At, 0, 0); PG8_STAGE(PG8_SA(1, 1), a1 + hstep, voffA);
            PG8_WAIT_L(8); PG8_BAR; PG8_WAIT_L(0); PG8_MMA(0, 0, At, B0); PG8_BAR; PG8_SCHED;
            PG8_LDB(B1, 0, 1); PG8_STAGE(PG8_SB(0, 0), b2, voffB);
            PG8_BAR; PG8_WAIT_L(0); PG8_MMA(0, 1, At, B1); PG8_BAR;
            PG8_LDA(At, 0, 1); PG8_STAGE(PG8_SA(0, 0), a2, voffA);
            PG8_BAR; PG8_WAIT_L(0); PG8_MMA(1, 0, At, B0); PG8_BAR; PG8_SCHED;
            PG8_STAGE(PG8_SB(0, 1), b2 + hstep, voffB);
            PG8_WAIT_V(6); PG8_BAR; PG8_MMA(1, 1, At, B1); PG8_BAR;
            PG8_LDB(B0, 1, 0); PG8_SCHED; PG8_LDA(At, 1, 0); PG8_STAGE(PG8_SA(0, 1), a2 + hstep, voffA);
            PG8_WAIT_L(8); PG8_BAR; PG8_WAIT_L(0); PG8_MMA(0, 0, At, B0); PG8_BAR; PG8_SCHED;
            PG8_LDB(B1, 1, 1); PG8_STAGE(PG8_SB(1, 0), b3, voffB);
            PG8_BAR; PG8_WAIT_L(0); PG8_MMA(0, 1, At, B1); PG8_BAR;
            PG8_LDA(At, 1, 1); PG8_STAGE(PG8_SA(1, 0), a3, voffA);
            PG8_BAR; PG8_WAIT_L(0); PG8_MMA(1, 0, At, B0); PG8_BAR; PG8_SCHED;
            PG8_STAGE(PG8_SB(1, 1), b3 + hstep, voffB);
            PG8_WAIT_V(6); PG8_BAR; PG8_MMA(1, 1, At, B1); PG8_BAR;
            }
        }
        if constexpr (ALIGN_EPI) { if (wr == 0) PG8_BAR; }
        if constexpr (!Epi::AFTER_DRAIN) { E(acc, cur, wr, wc, fr, fq, lds); S.done(cur); }
        if (!has_next) break;
#pragma unroll
        for (int a = 0; a < 2; ++a)
#pragma unroll
            for (int b = 0; b < 2; ++b)
#pragma unroll
                for (int m = 0; m < 4; ++m)
#pragma unroll
                    for (int n = 0; n < 2; ++n) acc[a][b][m][n] = (f32x4){0.f, 0.f, 0.f, 0.f};
        cur = nxt; cA = nA; cB = nB; ++ui;
        if constexpr (ALIGN_EPI) { if (wr == 1) PG8_BAR; }
    }
    PG8_WAIT_V(0);
    if constexpr (!ALIGN_EPI) { if (wr == 0) PG8_BAR; }
    PG8_BAR;
    if constexpr (Epi::AFTER_DRAIN) { E.fused(acc, cur, wr, wc, fr, fq, lds, wid, lane); S.done(cur); }
#undef PG8_SA
#undef PG8_SB
#undef PG8_STAGE
#undef PG8_LDA
#undef PG8_LDB
#undef PG8_MMA
#undef PG8_WAIT_V
#undef PG8_WAIT_L
#undef PG8_BAR
#undef PG8_SCHED
}
}

namespace att {
#define ALAS __attribute__((address_space(3)))
typedef unsigned short bf16_t;
typedef short bf16x8 __attribute__((ext_vector_type(8)));
typedef short s16x4 __attribute__((ext_vector_type(4)));
typedef float f32x16 __attribute__((ext_vector_type(16)));
typedef float f32x4 __attribute__((ext_vector_type(4)));
typedef unsigned u32x4 __attribute__((ext_vector_type(4)));
constexpr int KVBLK = 64, QBLK = 32, SHM_K = 16384, SHM_V = 16384;
constexpr int GRP_BYTES = 2 * SHM_V + 2 * SHM_K + 512;
constexpr int SCR_OFF = 2 * GRP_BYTES;
constexpr int LDS_NEED = SCR_OFF + 8 * 256;
constexpr float SCALE = 0.08838834764831845f, THR = 8.f;
#define KSWZ(row, colB) ((row) * 256 + ((colB) ^ (((row) & 7) << 4)))
#define SBAR() __builtin_amdgcn_sched_barrier(0)
__device__ __forceinline__ int v_st(int k, int c) { const int kk = (k & ~0xC) | ((k & 4) << 1) | ((k & 8) >> 1); return ((kk >> 3) * 4 + (c >> 5)) * 512 + ((kk & 7) * 32 + (c & 31)) * 2; }
__device__ __forceinline__ int v_rd_base(int lane) { return ((lane & 3) << 3) | (((lane >> 2) & 3) << 6) | (((lane >> 4) & 1) << 5) | (((lane >> 5) & 1) << 8); }
__device__ __forceinline__ int crow(int r, int hi) { return (r & 3) + 8 * (r >> 2) + 4 * hi; }
__device__ __forceinline__ unsigned cvtpk(float lo, float hi) { unsigned r; asm volatile("v_cvt_pk_bf16_f32 %0, %1, %2" : "=v"(r) : "v"(lo), "v"(hi)); return r; }
__device__ __forceinline__ void mask_tile(f32x16& p0, f32x16& p1, int dq, unsigned W) {
    const float NEG = -__builtin_inff();
#pragma unroll
    for (int r = 0; r < 16; ++r) { const int c = (r & 3) + 8 * (r >> 2);
        if ((unsigned)(dq - c) >= W) p0[r] = NEG;
        if ((unsigned)(dq - c - 32) >= W) p1[r] = NEG; }
}
__device__ __forceinline__ void partialSM(f32x16& p0, f32x16& p1, float& m_reg, float& mn, float& alpha) {
    float pmax = p0[0];
#pragma unroll
    for (int r = 1; r < 16; ++r) pmax = fmaxf(pmax, p0[r]);
#pragma unroll
    for (int r = 0; r < 16; ++r) pmax = fmaxf(pmax, p1[r]);
    { auto rr = __builtin_amdgcn_permlane32_swap(__float_as_uint(pmax), __float_as_uint(pmax), false, false);
      pmax = fmaxf(__uint_as_float(rr[0]), __uint_as_float(rr[1])); }
    constexpr float C2 = 1.4426950408889634f * SCALE;
    if (__builtin_expect(__all((pmax - m_reg) * SCALE <= THR), 1)) { mn = m_reg; alpha = 1.f; }
    else { mn = fmaxf(m_reg, pmax); alpha = __builtin_amdgcn_exp2f((m_reg - mn) * C2); m_reg = mn; }
    const float mnL = -mn * C2;
#pragma unroll
    for (int r = 0; r < 16; ++r) p0[r] = fmaf(p0[r], C2, mnL);
#pragma unroll
    for (int r = 0; r < 16; ++r) p1[r] = fmaf(p1[r], C2, mnL);
#pragma unroll
    for (int r = 0; r < 16; ++r) p0[r] = __builtin_amdgcn_exp2f(p0[r]);
}
__device__ __forceinline__ void finishSM(f32x16& p0, f32x16& p1, float alpha, float& l_reg, bf16x8& pa0, bf16x8& pa1, bf16x8& pa2, bf16x8& pa3) {
#pragma unroll
    for (int r = 0; r < 16; ++r) p1[r] = __builtin_amdgcn_exp2f(p1[r]);
    float ps = 0;
#pragma unroll
    for (int r = 0; r < 16; ++r) ps += p0[r];
#pragma unroll
    for (int r = 0; r < 16; ++r) ps += p1[r];
    { auto rr = __builtin_amdgcn_permlane32_swap(__float_as_uint(ps), __float_as_uint(ps), false, false);
      ps = __uint_as_float(rr[0]) + __uint_as_float(rr[1]); }
    l_reg = l_reg * alpha + ps;
#define PK4(P, B_, OUT) do { unsigned a0 = cvtpk(P[B_+0], P[B_+1]), a1 = cvtpk(P[B_+2], P[B_+3]);                          \
        unsigned b0 = cvtpk(P[B_+4], P[B_+5]), b1 = cvtpk(P[B_+6], P[B_+7]);                                             \
        auto r0 = __builtin_amdgcn_permlane32_swap(a0, b0, false, false); auto r1 = __builtin_amdgcn_permlane32_swap(a1, b1, false, false); \
        u32x4 w = {r0[0], r1[0], r0[1], r1[1]}; OUT = __builtin_bit_cast(bf16x8, w); } while (0)
    PK4(p0, 0, pa0); PK4(p0, 8, pa1); PK4(p1, 0, pa2); PK4(p1, 8, pa3);
#undef PK4
}
__device__ __forceinline__ void qkt(f32x16& p0, f32x16& p1, const ALAS char* Kb, int r32, int hi, const bf16x8* qr) {
    p0 = f32x16{}; p1 = f32x16{};
    const ALAS char* kb[4];
#pragma unroll
    for (int dd = 0; dd < 4; ++dd) kb[dd] = Kb + KSWZ(r32, (dd * 16 + hi * 8) * 2);
#pragma unroll
    for (int d0 = 0; d0 < 8; ++d0) { const ALAS char* a = kb[d0 & 3] + (d0 >> 2) * 128;
        const bf16x8 b0 = *(const ALAS bf16x8*)a;
        const bf16x8 b1 = *(const ALAS bf16x8*)(a + 32 * 256);
        p0 = __builtin_amdgcn_mfma_f32_32x32x16_bf16(b0, qr[d0], p0, 0, 0, 0);
        p1 = __builtin_amdgcn_mfma_f32_32x32x16_bf16(b1, qr[d0], p1, 0, 0, 0); }
}
__device__ __forceinline__ void pv_tile(f32x16* o, int vb0, bf16x8 pa0, bf16x8 pa1, bf16x8 pa2, bf16x8 pa3) {
#define TRRD(dst, off) asm volatile("ds_read_b64_tr_b16 %0, %1 offset:%2" : "=&v"(dst) : "v"(vb0), "i"(off) : "memory")
#define PV_KS(ks, pa) do { s16x4 l0, l1, l2, l3, h0, h1, h2, h3; constexpr int b_ = (ks) * 4096;   \
        TRRD(l0, b_); TRRD(h0, b_ + 2048); TRRD(l1, b_ + 512); TRRD(h1, b_ + 512 + 2048); TRRD(l2, b_ + 1024); TRRD(h2, b_ + 1024 + 2048); TRRD(l3, b_ + 1536); TRRD(h3, b_ + 1536 + 2048); \
        asm volatile("s_waitcnt lgkmcnt(0)" ::: "memory"); SBAR();   \
        o[0] = __builtin_amdgcn_mfma_f32_32x32x16_bf16(pa, (bf16x8){l0[0], l0[1], l0[2], l0[3], h0[0], h0[1], h0[2], h0[3]}, o[0], 0, 0, 0);   \
        o[1] = __builtin_amdgcn_mfma_f32_32x32x16_bf16(pa, (bf16x8){l1[0], l1[1], l1[2], l1[3], h1[0], h1[1], h1[2], h1[3]}, o[1], 0, 0, 0);   \
        o[2] = __builtin_amdgcn_mfma_f32_32x32x16_bf16(pa, (bf16x8){l2[0], l2[1], l2[2], l2[3], h2[0], h2[1], h2[2], h2[3]}, o[2], 0, 0, 0);   \
        o[3] = __builtin_amdgcn_mfma_f32_32x32x16_bf16(pa, (bf16x8){l3[0], l3[1], l3[2], l3[3], h3[0], h3[1], h3[2], h3[3]}, o[3], 0, 0, 0); } while (0)
    PV_KS(0, pa0); PV_KS(1, pa1); PV_KS(2, pa2); PV_KS(3, pa3);
#undef PV_KS
#undef TRRD
}
struct Unit { const bf16_t* Q; const bf16_t* K; const bf16_t* V; bf16_t* O; long ldq, ldk; int P0, W, j_lo, NT; float* lse; long lse_ld; int dry; };
constexpr int FB_OFF = LDS_NEED;
template <bool SHARED, bool BIAS>
__device__ __forceinline__ void attn_unit(const Unit& U, ALAS char* lds) {
    const int tid = threadIdx.x, wid = __builtin_amdgcn_readfirstlane(tid >> 6), lane = tid & 63, r32 = lane & 31, hi = lane >> 5;
    const int grp = SHARED ? 0 : (wid >> 2), gw = SHARED ? wid : (wid & 3), gtid = SHARED ? tid : (tid & 255);
    ALAS char* V_lds = lds + grp * GRP_BYTES; ALAS char* K_lds = V_lds + 2 * SHM_V;
    ALAS float* ws = (ALAS float*)(lds + SCR_OFF) + wid * 64; ALAS float* li_l = ws; ALAS float* al_l = ws + 32;
    constexpr int NST = SHARED ? 2 : 4, RSTEP = SHARED ? 32 : 16;
    const int sr = gtid >> 4, sc = (gtid & 15) * 8;
    bf16x8 qr[8];
    { const unsigned qoff = (unsigned)(gw * QBLK + r32) * (unsigned)U.ldq + hi * 8;
#pragma unroll
      for (int d0 = 0; d0 < 8; ++d0) qr[d0] = *(const bf16x8*)(U.Q + (qoff + d0 * 16)); }
    bf16x8 stk[NST], stv[NST];
    const unsigned soff = (unsigned)sr * (unsigned)U.ldk + sc, sstep = (unsigned)RSTEP * (unsigned)U.ldk;
#define LOADT(t) do { const size_t k0_ = (size_t)(U.j_lo + (t)) * KVBLK; const bf16_t* kt_ = U.K + k0_ * U.ldk; const bf16_t* vt_ = U.V + k0_ * U.ldk; \
        _Pragma("unroll") for (int i = 0; i < NST; ++i) { stk[i] = *(const bf16x8*)(kt_ + (soff + i * sstep)); stv[i] = *(const bf16x8*)(vt_ + (soff + i * sstep)); } \
        } while (0)
#define WRITET(bf) do { _Pragma("unroll") for (int i = 0; i < NST; ++i) { const int row_ = sr + i * RSTEP; \
        *(ALAS bf16x8*)(K_lds + (bf) * SHM_K + KSWZ(row_, sc * 2)) = stk[i]; *(ALAS bf16x8*)(V_lds + (bf) * SHM_V + v_st(row_, sc)) = stv[i]; } \
        } while (0)
    LOADT(0); WRITET(0);
    if (U.NT > 1) LOADT(1);
    const int qlo = U.P0 + gw * QBLK, qm = qlo + r32 - 4 * hi;
    float m_reg = -1e30f, l_reg = 0.f; f32x16 o[4] = {};
    const int vbase = (int)(uintptr_t)V_lds + v_rd_base(lane);
    for (int t = 0; t < U.NT; ++t) {
        asm volatile("s_waitcnt lgkmcnt(0)\n\ts_barrier" ::: "memory");
        const int bf = t & 1;
        if (t + 1 < U.NT) WRITET(bf ^ 1);
        if (t + 2 < U.NT) LOADT(t + 2);
        const int kb = (U.j_lo + t) * KVBLK;
        const bool act = (kb <= qlo + QBLK - 1) && (kb + KVBLK - 1 >= qlo - U.W + 1);
        if (act) {
            f32x16 p0, p1; float mn, alpha; bf16x8 pa0, pa1, pa2, pa3;
            qkt(p0, p1, K_lds + bf * SHM_K, r32, hi, qr);
            if (BIAS) { const ALAS char* bp = lds + FB_OFF + kb * 4 + hi * 16;
#pragma unroll
                for (int g = 0; g < 4; ++g) { const f32x4 b0 = *(const ALAS f32x4*)(bp + g * 32), b1 = *(const ALAS f32x4*)(bp + 128 + g * 32);
#pragma unroll
                    for (int j = 0; j < 4; ++j) { p0[4 * g + j] += b0[j]; p1[4 * g + j] += b1[j]; } } }
            if (kb + KVBLK - 1 > qlo || kb <= qlo + QBLK - 1 - U.W) mask_tile(p0, p1, qm - kb, (unsigned)U.W);
            partialSM(p0, p1, m_reg, mn, alpha);
            if (__any(alpha < 1.f)) { if (hi == 0) al_l[r32] = alpha; asm volatile("s_waitcnt lgkmcnt(0)" ::: "memory");
#pragma unroll
                for (int d_ = 0; d_ < 4; ++d_)
#pragma unroll
                    for (int r = 0; r < 16; ++r) o[d_][r] *= al_l[crow(r, hi)]; }
            finishSM(p0, p1, alpha, l_reg, pa0, pa1, pa2, pa3); SBAR();
            pv_tile(o, vbase + bf * SHM_V, pa0, pa1, pa2, pa3);
        }
    }
    if (hi == 0) { li_l[r32] = l_reg; if (U.lse && !U.dry) U.lse[(size_t)(gw * QBLK + r32) * U.lse_ld] = m_reg * SCALE + __logf(l_reg); }
    asm volatile("s_waitcnt lgkmcnt(0)" ::: "memory");
    float rli[16];
#pragma unroll
    for (int r = 0; r < 16; ++r) rli[r] = __builtin_amdgcn_rcpf(li_l[crow(r, hi)]);
    const unsigned ooff = (unsigned)(gw * QBLK + 4 * hi) * (unsigned)U.ldq + r32;
#pragma unroll
    for (int r = 0; r < 16; ++r) { const unsigned orow = (r & 3) + 8 * (r >> 2);
#pragma unroll
        for (int d0 = 0; d0 < 4; ++d0) { const float v = o[d0][r] * rli[r]; const float vn = __shfl_xor(v, 1);
            if ((r32 & 1) == 0 && !U.dry) *(unsigned*)(U.O + (ooff + orow * (unsigned)U.ldq + d0 * 32)) = cvtpk(v, vn); } }
    asm volatile("s_waitcnt lgkmcnt(0)\n\ts_barrier" ::: "memory");
#undef LOADT
#undef WRITET
}
template <bool BIAS>
__device__ __forceinline__ void attn_unit_pipe(const Unit& U, ALAS char* lds) {
    int tid = threadIdx.x; asm volatile("" : "+v"(tid));
    const int wid = __builtin_amdgcn_readfirstlane(tid >> 6), lane = tid & 63, r32 = lane & 31, hi = lane >> 5;
    ALAS char* V_lds = lds; ALAS char* K_lds = lds + 2 * SHM_V;
    ALAS float* ws = (ALAS float*)(lds + SCR_OFF) + wid * 64; ALAS float* li_l = ws; ALAS float* al_l = ws + 32;
    constexpr int NST = 2, RSTEP = 32;
    const int sr = tid >> 4, sc = (tid & 15) * 8;
    bf16x8 qr[8];
    { const unsigned qoff = (unsigned)(wid * QBLK + r32) * (unsigned)U.ldq + hi * 8;
#pragma unroll
      for (int d0 = 0; d0 < 8; ++d0) qr[d0] = *(const bf16x8*)(U.Q + (qoff + d0 * 16)); }
    bf16x8 stk[NST], stv[NST];
    const unsigned soff = (unsigned)sr * (unsigned)U.ldk + sc, sstep = (unsigned)RSTEP * (unsigned)U.ldk;
#define LOADT(t) do { const size_t k0_ = (size_t)(U.j_lo + (t)) * KVBLK; const bf16_t* kt_ = U.K + k0_ * U.ldk; const bf16_t* vt_ = U.V + k0_ * U.ldk; \
        _Pragma("unroll") for (int i = 0; i < NST; ++i) { stk[i] = *(const bf16x8*)(kt_ + (soff + i * sstep)); stv[i] = *(const bf16x8*)(vt_ + (soff + i * sstep)); } \
        } while (0)
#define WRITET(slot) do { _Pragma("unroll") for (int i = 0; i < NST; ++i) { const int row_ = sr + i * RSTEP; \
        *(ALAS bf16x8*)(K_lds + (slot) * SHM_K + KSWZ(row_, sc * 2)) = stk[i]; *(ALAS bf16x8*)(V_lds + (slot) * SHM_V + v_st(row_, sc)) = stv[i]; } \
        } while (0)
#define BARRIER() asm volatile("s_waitcnt lgkmcnt(0)\n\ts_barrier" ::: "memory")
    const int NT = U.NT;
    const int qlo = U.P0 + wid * QBLK, qm = qlo + r32 - 4 * hi;
    float m_reg = -1e30f, l_reg = 0.f; f32x16 o[4] = {};
    const int vbase = (int)(uintptr_t)V_lds + v_rd_base(lane);
#define KBASE(t) ((U.j_lo + (t)) * KVBLK)
#define ACTT(t) ((KBASE(t) <= qlo + QBLK - 1) && (KBASE(t) + KVBLK - 1 >= qlo - U.W + 1))
#define QKT(P0_, P1_, t) do { if (ACTT(t)) qkt(P0_, P1_, K_lds + ((t) & 1) * SHM_K, r32, hi, qr); else { const float NEG_ = -__builtin_inff(); \
        _Pragma("unroll") for (int r = 0; r < 16; ++r) { P0_[r] = NEG_; P1_[r] = NEG_; } } } while (0)
#define BMASK(P0_, P1_, t) do { if (ACTT(t)) { const int kb_ = KBASE(t); \
        if (BIAS) { const ALAS char* bp = lds + FB_OFF + kb_ * 4 + hi * 16; \
            _Pragma("unroll") for (int g = 0; g < 4; ++g) { const f32x4 b0 = *(const ALAS f32x4*)(bp + g * 32), b1 = *(const ALAS f32x4*)(bp + 128 + g * 32); \
                _Pragma("unroll") for (int j = 0; j < 4; ++j) { P0_[4 * g + j] += b0[j]; P1_[4 * g + j] += b1[j]; } } } \
        if (kb_ + KVBLK - 1 > qlo || kb_ <= qlo + QBLK - 1 - U.W) mask_tile(P0_, P1_, qm - kb_, (unsigned)U.W); } } while (0)
#define RESC(a) do { if (__any((a) < 1.f)) { if (hi == 0) al_l[r32] = (a); asm volatile("s_waitcnt lgkmcnt(0)" ::: "memory"); \
        _Pragma("unroll") for (int d_ = 0; d_ < 4; ++d_) _Pragma("unroll") for (int r = 0; r < 16; ++r) o[d_][r] *= al_l[crow(r, hi)]; } } while (0)
    f32x16 pA0, pA1, pB0, pB1; float mnA, mnB, alA, alB; bf16x8 pa0, pa1, pa2, pa3;
    LOADT(0); WRITET(0); BARRIER();
    LOADT(1);
    QKT(pA0, pA1, 0); BMASK(pA0, pA1, 0); partialSM(pA0, pA1, m_reg, mnA, alA);
    WRITET(1); BARRIER();
    if (NT > 2) LOADT(2);
#define HALF_STEP(PX0, PX1, mnX, alX, PY0, PY1, alY, t) do { \
        SBAR(); QKT(PX0, PX1, t); \
        finishSM(PY0, PY1, alY, l_reg, pa0, pa1, pa2, pa3); SBAR(); \
        if (ACTT((t) - 1)) pv_tile(o, vbase + (((t) - 1) & 1) * SHM_V, pa0, pa1, pa2, pa3); \
        BMASK(PX0, PX1, t); partialSM(PX0, PX1, m_reg, mnX, alX); \
        BARRIER(); \
        if ((t) + 1 < NT) { WRITET(((t) + 1) & 1); if ((t) + 2 < NT) LOADT((t) + 2); } \
        RESC(alX); BARRIER(); } while (0)
    for (int t = 1; t + 1 < NT; t += 2) {
        HALF_STEP(pB0, pB1, mnB, alB, pA0, pA1, alA, t);
        HALF_STEP(pA0, pA1, mnA, alA, pB0, pB1, alB, t + 1);
    }
    HALF_STEP(pB0, pB1, mnB, alB, pA0, pA1, alA, NT - 1);
    finishSM(pB0, pB1, alB, l_reg, pa0, pa1, pa2, pa3); SBAR();
    if (ACTT(NT - 1)) pv_tile(o, vbase + ((NT - 1) & 1) * SHM_V, pa0, pa1, pa2, pa3);
#undef HALF_STEP
#undef RESC
#undef BMASK
#undef QKT
#undef ACTT
#undef KBASE
    if (hi == 0) li_l[r32] = l_reg;
    asm volatile("s_waitcnt lgkmcnt(0)" ::: "memory");
    float rli[16];
#pragma unroll
    for (int r = 0; r < 16; ++r) rli[r] = __builtin_amdgcn_rcpf(li_l[crow(r, hi)]);
    const unsigned ooff = (unsigned)(wid * QBLK + 4 * hi) * (unsigned)U.ldq + r32;
#pragma unroll
    for (int r = 0; r < 16; ++r) { const unsigned orow = (r & 3) + 8 * (r >> 2);
#pragma unroll
        for (int d0 = 0; d0 < 4; ++d0) { const float v = o[d0][r] * rli[r]; const float vn = __shfl_xor(v, 1);
            if ((r32 & 1) == 0 && !U.dry) *(unsigned*)(U.O + (ooff + orow * (unsigned)U.ldq + d0 * 32)) = cvtpk(v, vn); } }
    BARRIER();
#undef BARRIER
#undef LOADT
#undef WRITET
}
#undef SBAR
}

constexpr int BATCH = 16, SEQ = 2048, DM = 2048, M = BATCH * SEQ, HD = 128;
constexpr int NQKV = 9216, WA = 1024, DFF = 5632, NFFN = 2 * DFF, NKV = 4096, NKVF = 4352;
constexpr int MODS_LD = 28672;
constexpr float EPS = 1e-6f;
constexpr int NWAVES = 8, NPHASE = 13;
#ifndef PROBE_DUP
#define PROBE_DUP 0
#endif
#ifndef MK_N_LAUNCHES
#define MK_N_LAUNCHES 1
#endif
constexpr size_t MiB = 1u << 20;
constexpr size_t WS_ROPE = 1 * MiB, WS_MODS = 2 * MiB, WS_LOGF = 4 * MiB, WS_FB = 6 * MiB, WS_LSE = 8 * MiB;
constexpr size_t WS_WQKV = 16 * MiB, WS_WOA = 52 * MiB, WS_WKV = 56 * MiB, WS_WQB = 73 * MiB, WS_WOB = 81 * MiB, WS_WFI = 89 * MiB, WS_WFO = 177 * MiB;
constexpr size_t WS_H = 224 * MiB, WS_BIG = 352 * MiB, WS_OCOMB = 928 * MiB, WS_END = 992 * MiB;
constexpr size_t WS_H2 = 704 * MiB, WS_QB = 832 * MiB, WS_KV = 352 * MiB;
constexpr size_t WS_XB = 704 * MiB;
constexpr size_t WS_SW = 11 * MiB, WS_RSS = 13 * MiB;
constexpr size_t SW_OFF0 = 0, SW_OFF1 = 16 * 11264, SW_OFF2 = SW_OFF1 + 16 * 4352, SW_OFF3 = SW_OFF2 + 16 * 2048;
constexpr int LDS_BYTES = 147456;

#define LAS __attribute__((address_space(3)))
typedef unsigned short bf16;
#define XB_TMO      128
#define XB_XCNT(j)  (256  + 64 * (j))
#define XB_XSUB(j)  (1280 + 64 * (j))
#define XB_XGEN(j)  (2304 + 64 * (j))
#define XB_TOP      3328
#define XB_TOPGEN   3392
#define XCD_BAR_WORDS 3456
#define XB_SPIN_CAP (1u << 18)

__device__ __forceinline__ unsigned xb_ld(unsigned* p)              { return __hip_atomic_load(p, __ATOMIC_RELAXED, __HIP_MEMORY_SCOPE_AGENT); }
__device__ __forceinline__ unsigned xb_add(unsigned* p, unsigned v) { return __hip_atomic_fetch_add(p, v, __ATOMIC_RELAXED, __HIP_MEMORY_SCOPE_AGENT); }
__device__ __forceinline__ unsigned xb_xcc_id() { return (unsigned)__builtin_amdgcn_s_getreg((3 << 11) | 20) & 0xFu; }
#define XB_SPIN(cond, bar) do { unsigned _sp = 0; while (cond) { __builtin_amdgcn_s_sleep(1); \
    if ((++_sp & 255u) == 0u) { if (xb_ld(&(bar)[XB_TMO])) break; if (_sp > XB_SPIN_CAP) { atomicAdd(&(bar)[XB_TMO], 1u); break; } } } } while (0)

struct XcdBarrier {
    unsigned* bar; unsigned x;
    volatile LAS unsigned* st;
};

__device__ __forceinline__ XcdBarrier xcd_barrier_post(unsigned* bar, volatile LAS unsigned* st) {
    XcdBarrier b; b.bar = bar; b.x = xb_xcc_id(); b.st = st;
    if (threadIdx.x == 0) (void)xb_add(&bar[XB_XCNT(b.x)], 1u);
    return b;
}
__device__ __forceinline__ void xcd_barrier_complete(unsigned* bar, unsigned x, unsigned& nloc, unsigned& nx) {
    const unsigned G = gridDim.x * gridDim.y * gridDim.z;
    unsigned sum, cnt, mine, sp = 0u;
    for (;;) {
        sum = 0u; cnt = 0u; mine = 0u;
#pragma unroll
        for (unsigned j = 0; j < 16; ++j) { const unsigned c = xb_ld(&bar[XB_XCNT(j)]); sum += c; cnt += (c > 0u) ? 1u : 0u; mine = (j == x) ? c : mine; }
        if (sum == G) break;
        __builtin_amdgcn_s_sleep(1);
        if ((++sp & 255u) == 0u) { if (xb_ld(&bar[XB_TMO])) break; if (sp > XB_SPIN_CAP) { atomicAdd(&bar[XB_TMO], 1u); break; } }
    }
    nloc = mine > 0u ? mine : 1u; nx = cnt > 0u ? cnt : 1u;
}

__device__ __forceinline__ void xcd_barrier(const XcdBarrier& b) {
    asm volatile("s_waitcnt vmcnt(0)" ::: "memory");
    __syncthreads();
    if (threadIdx.x == 0) {
        unsigned* bar = b.bar;
        __builtin_amdgcn_s_waitcnt(0);
        unsigned nloc = b.st[0], nx = b.st[1];
        if (nloc == 0u) { xcd_barrier_complete(bar, b.x, nloc, nx); b.st[0] = nloc; b.st[1] = nx; }
        const unsigned old = xb_add(&bar[XB_XSUB(b.x)], 1u);
        const unsigned gen = old / nloc;
        if (old + 1u == (gen + 1u) * nloc) {
            __builtin_amdgcn_fence(__ATOMIC_RELEASE, "agent");
            asm volatile("s_waitcnt vmcnt(0)" ::: "memory");
            const unsigned og = xb_add(&bar[XB_TOP], 1u);
            const unsigned tg = og / nx;
            if (og + 1u == (tg + 1u) * nx) xb_add(&bar[XB_TOPGEN], 1u);
            else XB_SPIN(xb_ld(&bar[XB_TOPGEN]) == tg, bar);
            __builtin_amdgcn_fence(__ATOMIC_ACQUIRE, "agent");
            xb_add(&bar[XB_XGEN(b.x)], 1u);
            asm volatile("s_waitcnt vmcnt(0)" ::: "memory");
        } else {
            XB_SPIN(xb_ld(&bar[XB_XGEN(b.x)]) == gen, bar);
            __builtin_amdgcn_fence(__ATOMIC_ACQUIRE, "agent");
            asm volatile("s_waitcnt vmcnt(0)" ::: "memory");
        }
    }
    __syncthreads();
}
typedef unsigned v4u __attribute__((ext_vector_type(4)));
typedef unsigned v2u __attribute__((ext_vector_type(2)));
typedef float f32x4 __attribute__((ext_vector_type(4)));
typedef float f32x2 __attribute__((ext_vector_type(2)));
__device__ __forceinline__ unsigned pk2(float lo, float hi) { unsigned r; asm volatile("v_cvt_pk_bf16_f32 %0, %1, %2" : "=v"(r) : "v"(lo), "v"(hi)); return r; }
__device__ __forceinline__ float bf_lo(unsigned w) { return __uint_as_float(w << 16); }
__device__ __forceinline__ float bf_hi(unsigned w) { return __uint_as_float(w & 0xffff0000u); }
__device__ __forceinline__ float wave_sum(float v) {
#pragma unroll
    for (int o = 1; o < 64; o <<= 1) v += __shfl_xor(v, o);
    return v;
}
struct Args { const float* in[21]; float* out; unsigned char* ws; int ph_lo, ph_hi; };
enum { I_X = 0, I_C, I_WADA, I_BADA, I_GNA, I_GNF, I_WQKVA, I_GQKA, I_WOA, I_WADAKV, I_BADAKV, I_GNKV, I_WKV, I_GKB, I_WF, I_BF, I_WQB, I_GQB, I_WOB, I_WFI, I_WFO };

constexpr int TSCR = 64 * 65 * 4;
__device__ __forceinline__ void transpose_item(const float* W, int K, int N, bf16* WT, int k0, int n0, int nd0, int kind, LAS float* scr, int lane) {
    const int lr = lane >> 4, lc = (lane & 15) * 4;
    f32x4 v[16];
    const float* wp = W + (size_t)(k0 + lr) * N + n0 + lc;
#pragma unroll
    for (int i = 0; i < 16; ++i) v[i] = *(const f32x4*)(wp + (size_t)(4 * i) * N);
#pragma unroll
    for (int i = 0; i < 16; ++i) { LAS float* d = scr + (4 * i + lr) * 65 + lc; d[0] = v[i].x; d[1] = v[i].y; d[2] = v[i].z; d[3] = v[i].w; }
    asm volatile("s_waitcnt lgkmcnt(0)" ::: "memory");
    const int c = lane & 7;
#pragma unroll
    for (int j = 0; j < 8; ++j) { const int n = (lane >> 3) + 8 * j; const LAS float* sp = scr + (8 * c) * 65 + n;
        v4u o; o.x = pk2(sp[0 * 65], sp[1 * 65]); o.y = pk2(sp[2 * 65], sp[3 * 65]); o.z = pk2(sp[4 * 65], sp[5 * 65]); o.w = pk2(sp[6 * 65], sp[7 * 65]);
        int nd = nd0 + n;
        if (kind == 2) { const int col = n0 + n, d = col & 127;
            if (col < 6144 && d < 32) nd = (col & ~31) + 8 * ((d & 15) >> 2) + 4 * (d >> 4) + (d & 3); }
        *(v4u*)(WT + (size_t)nd * K + k0 + 8 * c) = o; }
    asm volatile("s_waitcnt lgkmcnt(0)" ::: "memory");
}
__device__ __forceinline__ void transpose_matrix_items(const float* W, int K, int N, bf16* WT, int kind, int item, LAS float* scr, int lane) {
    const int nblk = N / 64, kb = item / nblk, nb = item % nblk, n0 = 64 * nb; int nd0 = n0;
    if (kind == 1) { const int half = n0 >= DFF, nn = n0 - half * DFF; nd0 = 256 * (nn >> 7) + 128 * half + (nn & 127); }
    transpose_item(W, K, N, WT, 64 * kb, n0, nd0, kind, scr, lane);
}
__device__ __forceinline__ void sincos_d(double a, double& s, double& c) {
    const double n = rint(a * 0.6366197723675814); const int q = (int)n & 3;
    double r = fma(-n, 1.5707963267948966, a); r = fma(-n, 6.123233995736766e-17, r);
    const double r2 = r * r;
    double sp = -7.647163731819816e-13; sp = fma(sp, r2, 1.6059043836821613e-10); sp = fma(sp, r2, -2.505210838544172e-08); sp = fma(sp, r2, 2.7557319223985893e-06);
    sp = fma(sp, r2, -1.984126984126984e-04); sp = fma(sp, r2, 8.333333333333333e-03); sp = fma(sp, r2, -1.6666666666666666e-01); sp = fma(sp * r2, r, r);
    double cp = 4.779477332387385e-14; cp = fma(cp, r2, -1.1470745597729725e-11); cp = fma(cp, r2, 2.08767569878681e-09); cp = fma(cp, r2, -2.755731922398589e-07);
    cp = fma(cp, r2, 2.48015873015873e-05); cp = fma(cp, r2, -1.388888888888889e-03); cp = fma(cp, r2, 4.1666666666666664e-02); cp = fma(cp, r2, -0.5); cp = fma(cp, r2, 1.0);
    s = (q == 0) ? sp : (q == 1) ? cp : (q == 2) ? -sp : -cp;
    c = (q == 0) ? cp : (q == 1) ? -sp : (q == 2) ? -cp : sp;
}
__device__ __forceinline__ float rope_inv(int i) {
    switch (i) { case 0: return 1.0f; case 1: return 0.44036659598350525f; case 2: return 0.1939227432012558f; case 3: return 0.08539710193872452f;
        case 4: return 0.03760603070259094f; case 5: return 0.01656043902039528f; case 6: return 0.007292664609849453f; case 7: return 0.0032114458736032248f;
        case 8: return 0.0014142135623842478f; case 9: return 0.000622772378847003f; case 10: return 0.00027424818836152554f; case 11: return 0.00012076973507646471f;
        case 12: return 5.318296098266728e-05f; case 13: return 2.34199997066753e-05f; case 14: return 1.0313386155758053e-05f; default: return 4.541670477919979e-06f; }
}
__device__ __forceinline__ void phase_prologue(const Args& a, LAS unsigned char* lds) {
    const int tid = threadIdx.x, lane = tid & 63, wave = __builtin_amdgcn_readfirstlane(tid >> 6), G = gridDim.x;
    unsigned char* ws = a.ws;
    for (int tk0 = blockIdx.x; tk0 < (MODS_LD / 128) * ((PROBE_DUP == 23) ? 1 + (a.ph_hi > 0) : 1); tk0 += G) { const int tk = tk0 % (MODS_LD / 128);
        LAS float* ct = (LAS float*)lds;
        for (int idx = tid; idx < BATCH * DM; idx += NWAVES * 64) { const int b = idx >> 11, k = idx & 2047; const float v = a.in[I_C][idx]; ct[k * 16 + b] = v / (1.f + __expf(-v)); }
        __syncthreads();
        const int col0 = tk * 128; const float* W; int pitch, wc0; const float* bias;
        if (col0 < 2 * 12288) { const int l = col0 / 12288; wc0 = col0 - l * 12288; W = a.in[I_WADA] + (size_t)l * DM * 12288; pitch = 12288; bias = a.in[I_BADA] + col0; }
        else { wc0 = col0 - 2 * 12288; W = a.in[I_WADAKV]; pitch = 4096; bias = a.in[I_BADAKV] + wc0; }
        float acc[16][2];
#pragma unroll
        for (int b = 0; b < 16; ++b) { acc[b][0] = 0.f; acc[b][1] = 0.f; }
        const float* wp = W + (size_t)(wave * 256) * pitch + wc0 + 2 * lane;
#pragma unroll 8
        for (int k = 0; k < 256; ++k) { const f32x2 wv = *(const f32x2*)(wp + (size_t)k * pitch); const LAS f32x4* cp = (const LAS f32x4*)(ct + (wave * 256 + k) * 16);
#pragma unroll
            for (int q = 0; q < 4; ++q) { const f32x4 cv = cp[q];
#pragma unroll
                for (int j = 0; j < 4; ++j) { acc[4 * q + j][0] = fmaf(cv[j], wv.x, acc[4 * q + j][0]); acc[4 * q + j][1] = fmaf(cv[j], wv.y, acc[4 * q + j][1]); } } }
        __syncthreads();
        LAS float* red = (LAS float*)lds;
#pragma unroll
        for (int b = 0; b < 16; ++b) { red[(wave * 16 + b) * 128 + 2 * lane] = acc[b][0]; red[(wave * 16 + b) * 128 + 2 * lane + 1] = acc[b][1]; }
        __syncthreads();
        float* mods = (float*)(ws + WS_MODS);
        for (int idx = tid; idx < 16 * 128; idx += NWAVES * 64) { const int b = idx >> 7, cc = idx & 127; float s = bias[cc];
#pragma unroll
            for (int w = 0; w < 8; ++w) s += red[(w * 16 + b) * 128 + cc];
            mods[(size_t)b * MODS_LD + col0 + cc] = s; }
        __syncthreads();
    }
    { float* rt = (float*)(ws + WS_ROPE);
      for (int idx = blockIdx.x * (NWAVES * 64) + tid; idx < SEQ * 16; idx += G * NWAVES * 64) { const int t = idx >> 4, i = idx & 15;
          const float ang = (float)t * rope_inv(i); double s, c; sincos_d((double)ang, s, c); rt[idx] = (float)c; rt[SEQ * 16 + idx] = (float)s; } }
    { bf16* wkv = (bf16*)(ws + WS_WKV) + (size_t)NKV * DM;
      for (int idx = blockIdx.x * (NWAVES * 64) + tid; idx < 256 * DM; idx += G * NWAVES * 64) { const int n = idx >> 11, k = idx & 2047;
          wkv[idx] = n < 16 ? (bf16)(pk2(a.in[I_WF][k * 16 + n], 0.f) & 0xffffu) : (bf16)0; } }
    { float* rss = (float*)(ws + WS_RSS); for (int idx = blockIdx.x * (NWAVES * 64) + tid; idx < 3 * M; idx += G * NWAVES * 64) rss[idx] = 0.f; }
    __syncthreads();
    LAS float* scr = (LAS float*)(lds + wave * TSCR);
    const int gw = blockIdx.x * NWAVES + wave, NGW = G * NWAVES;
    constexpr int I0 = (DM / 64) * (NQKV / 64), I1 = (WA / 64) * (DM / 64), I2 = (DM / 64) * (NKV / 64), I3 = (DM / 64) * (DM / 64), I5 = (DM / 64) * (NFFN / 64), I7 = (DFF / 64) * (DM / 64);
    constexpr int NIT = I0 + I1 + I2 + 2 * I3 + 2 * I5 + 2 * I7;
    for (int it = gw; it < NIT * ((PROBE_DUP == 24) ? 1 + (a.ph_hi > 0) : 1); it += NGW) {
        int r = it % NIT;
        if (r < I0) { transpose_matrix_items(a.in[I_WQKVA], DM, NQKV, (bf16*)(ws + WS_WQKV), 2, r, scr, lane); continue; } r -= I0;
        if (r < I1) { transpose_matrix_items(a.in[I_WOA], WA, DM, (bf16*)(ws + WS_WOA), 0, r, scr, lane); continue; } r -= I1;
        if (r < I2) { transpose_matrix_items(a.in[I_WKV], DM, NKV, (bf16*)(ws + WS_WKV), 0, r, scr, lane); continue; } r -= I2;
        if (r < I3) { transpose_matrix_items(a.in[I_WQB], DM, DM, (bf16*)(ws + WS_WQB), 0, r, scr, lane); continue; } r -= I3;
        if (r < I3) { transpose_matrix_items(a.in[I_WOB], DM, DM, (bf16*)(ws + WS_WOB), 0, r, scr, lane); continue; } r -= I3;
        if (r < 2 * I5) { const int l = r / I5; transpose_matrix_items(a.in[I_WFI] + (size_t)l * DM * NFFN, DM, NFFN, (bf16*)(ws + WS_WFI) + (size_t)l * NFFN * DM, 1, r - l * I5, scr, lane); continue; } r -= 2 * I5;
        { const int l = r / I7; transpose_matrix_items(a.in[I_WFO] + (size_t)l * DFF * DM, DFF, DM, (bf16*)(ws + WS_WFO) + (size_t)l * DM * DFF, 0, r - l * I7, scr, lane); }
    }
    __syncthreads();
}
template <bool DUAL>
__device__ __forceinline__ void phase_norm(const float* x, const float* g1, const float* sh1, const float* sc1, bf16* o1,
                                           const float* g2, const float* sh2, const float* sc2, bf16* o2) {
    const int lane = threadIdx.x & 63, wave = threadIdx.x >> 6; const int gw = blockIdx.x * NWAVES + wave, NGW = gridDim.x * NWAVES;
    f32x4 v[8];
    if (gw < M) { const f32x4* xr = (const f32x4*)(x + (size_t)gw * DM) + lane;
#pragma unroll
        for (int j = 0; j < 8; ++j) v[j] = xr[64 * j]; }
    for (int row = gw; row < M; row += NGW) {
        const int b = row >> 11; float s = 0.f;
        f32x4 nv[8]; const int nrow = row + NGW;
        if (nrow < M) { const f32x4* xr = (const f32x4*)(x + (size_t)nrow * DM) + lane;
#pragma unroll
            for (int j = 0; j < 8; ++j) nv[j] = xr[64 * j]; }
#pragma unroll
        for (int j = 0; j < 8; ++j) s += (v[j].x * v[j].x + v[j].y * v[j].y) + (v[j].z * v[j].z + v[j].w * v[j].w);
        const float rstd = 1.0f / sqrtf(wave_sum(s) * (1.f / DM) + EPS);
#pragma unroll
        for (int j = 0; j < 8; ++j) { const int col = 4 * lane + 256 * j;
            { const f32x4 gv = *(const f32x4*)(g1 + col), sh = *(const f32x4*)(sh1 + (size_t)b * MODS_LD + col), sc = *(const f32x4*)(sc1 + (size_t)b * MODS_LD + col);
              const f32x4 h = (v[j] * rstd * gv) * (sc + 1.f) + sh; v2u w; w.x = pk2(h.x, h.y); w.y = pk2(h.z, h.w); *(v2u*)(o1 + (size_t)row * DM + col) = w; }
            if (DUAL) { const f32x4 gv = *(const f32x4*)(g2 + col), sh = *(const f32x4*)(sh2 + (size_t)b * MODS_LD + col), sc = *(const f32x4*)(sc2 + (size_t)b * MODS_LD + col);
              const f32x4 h = (v[j] * rstd * gv) * (sc + 1.f) + sh; v2u w; w.x = pk2(h.x, h.y); w.y = pk2(h.z, h.w); *(v2u*)(o2 + (size_t)row * DM + col) = w; } }
#pragma unroll
        for (int j = 0; j < 8; ++j) v[j] = nv[j];
    }
}

__device__ __forceinline__ void phase_sw(const Args& a) {
    typedef short bf16x8_t __attribute__((ext_vector_type(8))); typedef float f32x16_t __attribute__((ext_vector_type(16)));
    const int lane = threadIdx.x & 63, wave = threadIdx.x >> 6; const int gw = blockIdx.x * NWAVES + wave, NGW = gridDim.x * NWAVES;
    unsigned char* ws = a.ws; const float* mods = (const float*)(ws + WS_MODS); float* SW = (float*)(ws + WS_SW);
    constexpr int T0 = NFFN / 32, T1 = NKVF / 32, T2 = DM / 32, NT = 2 * T0 + T1 + T2;
    const int m = lane & 31, kh = lane >> 5;
    for (int t = gw; t < NT; t += NGW) {
        const bf16* Bt; const float* sh; float* out; int nrows, r0;
        if (t < T0) { Bt = (const bf16*)(ws + WS_WFI); sh = mods + 6144; out = SW + SW_OFF0; nrows = NFFN; r0 = t * 32; }
        else if (t < T0 + T1) { Bt = (const bf16*)(ws + WS_WKV); sh = mods + 24576; out = SW + SW_OFF1; nrows = NKVF; r0 = (t - T0) * 32; }
        else if (t < T0 + T1 + T2) { Bt = (const bf16*)(ws + WS_WQB); sh = mods + 12288; out = SW + SW_OFF2; nrows = DM; r0 = (t - T0 - T1) * 32; }
        else { Bt = (const bf16*)(ws + WS_WFI) + (size_t)NFFN * DM; sh = mods + 12288 + 6144; out = SW + SW_OFF3; nrows = NFFN; r0 = (t - T0 - T1 - T2) * 32; }
        const bf16* ap = Bt + (size_t)(r0 + m) * DM + kh * 8; const float* bp = sh + (size_t)(m & 15) * MODS_LD + kh * 8;
        f32x16_t acc = {};
#pragma unroll 8
        for (int kk = 0; kk < DM / 16; ++kk) { const bf16x8_t av = *(const bf16x8_t*)(ap + kk * 16);
            const f32x4 b0 = *(const f32x4*)(bp + kk * 16), b1 = *(const f32x4*)(bp + kk * 16 + 4);
            v4u w; w.x = pk2(b0.x, b0.y); w.y = pk2(b0.z, b0.w); w.z = pk2(b1.x, b1.y); w.w = pk2(b1.z, b1.w);
            if (m >= 16) { w.x = 0; w.y = 0; w.z = 0; w.w = 0; }
            acc = __builtin_amdgcn_mfma_f32_32x32x16_bf16(av, __builtin_bit_cast(bf16x8_t, w), acc, 0, 0, 0); }
        if (m < 16) {
#pragma unroll
            for (int r = 0; r < 16; ++r) out[(size_t)m * nrows + r0 + (r & 3) + 8 * (r >> 2) + 4 * kh] = acc[r]; }
    }
}
template <bool ROPE>
__device__ __forceinline__ void phase_qknorm(bf16* buf, size_t pitch, int nchunk, const float* gains, int gshift, const float* rope, int dry = 0) {
    const int lane = threadIdx.x & 63, wave = threadIdx.x >> 6; const int gw = blockIdx.x * NWAVES + wave, NGW = gridDim.x * NWAVES;
    const int nq = nchunk >> 2, j = lane & 15; const long total = (long)M * nq;
    for (long it0 = gw; it0 < total; it0 += 4L * NGW) {
        v4u raw[4]; bf16* pp[4]; int ch[4], tok[4]; bool ok[4];
#pragma unroll
        for (int u = 0; u < 4; ++u) { const long it = it0 + (long)u * NGW; ok[u] = it < total; const long itc = ok[u] ? it : it0; tok[u] = (int)(itc / nq); ch[u] = (int)(itc % nq) * 4 + (lane >> 4);
            pp[u] = buf + (size_t)tok[u] * pitch + ch[u] * 128 + j * 8; raw[u] = *(const v4u*)pp[u]; }
#pragma unroll
        for (int u = 0; u < 4; ++u) {
            float x[8]; x[0] = bf_lo(raw[u].x); x[1] = bf_hi(raw[u].x); x[2] = bf_lo(raw[u].y); x[3] = bf_hi(raw[u].y); x[4] = bf_lo(raw[u].z); x[5] = bf_hi(raw[u].z); x[6] = bf_lo(raw[u].w); x[7] = bf_hi(raw[u].w);
            float ss = 0.f;
#pragma unroll
            for (int i = 0; i < 8; ++i) ss += x[i] * x[i];
            ss += __shfl_xor(ss, 1); ss += __shfl_xor(ss, 2); ss += __shfl_xor(ss, 4); ss += __shfl_xor(ss, 8);
            const float rstd = 1.0f / sqrtf(ss * (1.f / HD) + EPS);
            const float* gp = gains + (size_t)(ch[u] >> gshift) * HD + j * 8; const f32x4 g0 = *(const f32x4*)gp, g1 = *(const f32x4*)(gp + 4);
            float y[8];
#pragma unroll
            for (int i = 0; i < 4; ++i) { y[i] = x[i] * rstd * g0[i]; y[4 + i] = x[4 + i] * rstd * g1[i]; }
            if (ROPE) { const int pos = tok[u] & (SEQ - 1); const float* cp = rope + pos * 16 + (j & 1) * 8; const float* sp = cp + SEQ * 16;
#pragma unroll
                for (int i = 0; i < 8; ++i) { const float pv = __shfl_xor(y[i], 2); const float c = cp[i], s = sp[i];
                    const float r = (j < 2) ? (y[i] * c - pv * s) : (y[i] * c + pv * s); y[i] = (j < 4) ? r : y[i]; } }
            v4u w; w.x = pk2(y[0], y[1]); w.y = pk2(y[2], y[3]); w.z = pk2(y[4], y[5]); w.w = pk2(y[6], y[7]);
            if (ok[u] && !dry) *(v4u*)pp[u] = w;
        }
    }
}
__device__ __forceinline__ void phase_combine(const bf16* qkv, const float* lse, bf16* oc) {
    const int lane = threadIdx.x & 63, wave = threadIdx.x >> 6; const int gw = blockIdx.x * NWAVES + wave, NGW = gridDim.x * NWAVES;
    const int j = lane & 15; const long total = (long)M * 2;
    constexpr int UN = 4;
    for (long it0 = gw; it0 < total; it0 += (long)UN * NGW) {
        v4u raw[UN][3]; float l[UN][3]; int tok[UN], h[UN]; bool ok[UN];
#pragma unroll
        for (int u = 0; u < UN; ++u) { const long it = it0 + (long)u * NGW; ok[u] = it < total; const long itc = ok[u] ? it : it0; tok[u] = (int)(itc >> 1); h[u] = (int)(itc & 1) * 4 + (lane >> 4);
#pragma unroll
            for (int g = 0; g < 3; ++g) { raw[u][g] = *(const v4u*)(qkv + (size_t)tok[u] * NQKV + g * WA + h[u] * HD + j * 8); l[u][g] = lse[((size_t)g * M + tok[u]) * 8 + h[u]]; } }
#pragma unroll
        for (int u = 0; u < UN; ++u) {
            const float mx = fmaxf(l[u][0], fmaxf(l[u][1], l[u][2])); float e[3]; e[0] = __expf(l[u][0] - mx); e[1] = __expf(l[u][1] - mx); e[2] = __expf(l[u][2] - mx);
            const float inv = 1.f / (e[0] + e[1] + e[2]); float y[8];
#pragma unroll
            for (int i = 0; i < 8; ++i) y[i] = 0.f;
#pragma unroll
            for (int g = 0; g < 3; ++g) { const float al = e[g] * inv; const v4u r = raw[u][g];
                y[0] += al * bf_lo(r.x); y[1] += al * bf_hi(r.x); y[2] += al * bf_lo(r.y); y[3] += al * bf_hi(r.y);
                y[4] += al * bf_lo(r.z); y[5] += al * bf_hi(r.z); y[6] += al * bf_lo(r.w); y[7] += al * bf_hi(r.w); }
            v4u w; w.x = pk2(y[0], y[1]); w.y = pk2(y[2], y[3]); w.z = pk2(y[4], y[5]); w.w = pk2(y[6], y[7]);
            if (ok[u]) *(v4u*)(oc + (size_t)tok[u] * WA + h[u] * HD + j * 8) = w;
        }
    }
}
__device__ __forceinline__ void phase_scan(const float* logf, float* fb) {
    const int lane = threadIdx.x & 63, wave = threadIdx.x >> 6;
    if (wave != 0) return;
    for (int bh = blockIdx.x; bh < BATCH * 16; bh += gridDim.x) {
        const int b = bh >> 4, h = bh & 15; const float* p = logf + ((size_t)b * SEQ + lane * 32) * 16 + h;
        double tot = 0.0;
        for (int i = 0; i < 32; ++i) tot += (double)p[i * 16];
        double incl = tot;
#pragma unroll
        for (int o = 1; o < 64; o <<= 1) { const double t = __shfl_up(incl, o); if (lane >= o) incl += t; }
        double run = incl - tot;
        for (int i = 0; i < 32; ++i) { run += (double)p[i * 16]; fb[(size_t)bh * SEQ + lane * 32 + i] = (float)(-run * 11.313708498984761); }
    }
}
__device__ __forceinline__ void phase_attn_a(bf16* qkv, float* lse, LAS unsigned char* lds, int dry) {
    const int wid = __builtin_amdgcn_readfirstlane(threadIdx.x >> 6), half = wid >> 2;
    constexpr int NU = BATCH * 3 * 4 * 16;
    const int G_ = gridDim.x, bx_ = blockIdx.x; const int vcu_ = (G_ % 8 == 0) ? (bx_ % 8) * (G_ / 8) + bx_ / 8 : bx_;
    for (int u = vcu_; u < NU; u += G_) {
        const int g = u >> 10, rem = u & 1023, bhp = rem >> 4, idx = rem & 15, b = bhp >> 2, h = (bhp & 3) * 2 + half;
        int dil, res, qb;
        if (g == 0) { dil = 1; res = 0; qb = idx; } else if (g == 1) { dil = 4; res = idx & 3; qb = idx >> 2; } else { dil = 16; res = idx; qb = 0; }
        const size_t tok0 = (size_t)b * SEQ + res;
        att::Unit U;
        const bf16* base = qkv + tok0 * NQKV + h * HD;
        U.ldq = (long)NQKV * dil; U.ldk = U.ldq;
        U.Q = base + (size_t)g * WA + (size_t)(qb * 128) * U.ldq; U.O = (bf16*)U.Q;
        U.K = base + (size_t)(3 + g) * WA; U.V = base + (size_t)(6 + g) * WA;
        U.P0 = qb * 128; U.W = 129; U.j_lo = qb ? 2 * qb - 2 : 0; U.NT = qb ? 4 : 2;
        U.lse = lse + ((size_t)g * M + tok0 + (size_t)(qb * 128) * dil) * 8 + h; U.lse_ld = 8L * dil; U.dry = dry;
        att::attn_unit<false, false>(U, (ALAS char*)lds);
    }
}
__device__ __forceinline__ void phase_attn_b(bf16* qb_, const bf16* kv, const float* logf, const float* bfp, LAS unsigned char* lds, int dry) {
    const int G = gridDim.x, bx = blockIdx.x; const int vcu = (G % 8 == 0) ? (bx % 8) * (G / 8) + bx / 8 : bx;
    constexpr int NU = BATCH * 16 * 8;
    for (int u = (G == 256 ? 0 : bx); u < (G == 256 ? 8 : NU); u += (G == 256 ? 1 : G)) {
        int bh, qblk;
        if (G == 256) { const int j = vcu & 7, p = j & 3; bh = (vcu >> 3) * 8 + 2 * (u >> 1) + (j >> 2); qblk = (u & 1) ? p : 7 - p; }
        else { bh = u >> 3; qblk = u & 7; }
        const int b = bh >> 4, h = bh & 15;
        att::Unit U;
        U.ldq = DM; U.ldk = NKV;
        U.Q = qb_ + ((size_t)b * SEQ + qblk * 256) * DM + h * HD; U.O = (bf16*)U.Q;
        U.K = kv + (size_t)b * SEQ * NKV + h * HD; U.V = U.K + DM;
        U.P0 = qblk * 256; U.W = 1 << 30; U.j_lo = 0; U.NT = 4 * (qblk + 1);
        U.lse = nullptr; U.lse_ld = 0; U.dry = dry;
        { int tid = threadIdx.x; asm volatile("" : "+v"(tid));
          const int lane = tid & 63, wave = tid >> 6;
          const f32x4 zr = *(const f32x4*)(logf + (size_t)bh * SEQ + 4 * tid); const float bfv = bfp[h];
          float zv[4];
#pragma unroll
          for (int i = 0; i < 4; ++i) { const float z = zr[i] + bfv; zv[i] = fminf(z, 0.f) - __logf(1.f + __expf(-fabsf(z))); }
          const double s1 = (double)zv[0], s2 = s1 + (double)zv[1], s3 = s2 + (double)zv[2], s4 = s3 + (double)zv[3];
          double incl = s4;
#pragma unroll
          for (int o = 1; o < 64; o <<= 1) { const double t = __shfl_up(incl, o); if (lane >= o) incl += t; }
          LAS double* wt = (LAS double*)(lds + att::SCR_OFF);
          if (lane == 63) wt[wave] = incl;
          __syncthreads();
          double off = incl - s4;
          for (int w = 0; w < wave; ++w) off += wt[w];
          LAS float* fbl = (LAS float*)(lds + att::FB_OFF) + 4 * tid; const double c = -11.313708498984761;
          fbl[0] = (float)((off + s1) * c); fbl[1] = (float)((off + s2) * c); fbl[2] = (float)((off + s3) * c); fbl[3] = (float)((off + s4) * c);
          __syncthreads(); }
        att::attn_unit_pipe<true>(U, (ALAS char*)lds);
    }
}

using EpiQKV = pg8::EpiStore<true, false>; using EpiKVQ = pg8::EpiStore<false, true>;
using EpiR5 = pg8::EpiResid<1, false, true>; using EpiR7 = pg8::EpiResid<2, true, true>; using EpiR10 = pg8::EpiResid<1, true, true>; using EpiR12 = pg8::EpiResid<0, true, false>;
__global__ void __launch_bounds__(NWAVES * 64) yoco_fwd(Args a) {
    extern __shared__ __attribute__((aligned(16))) unsigned char lds_raw[];
    LAS unsigned char* lds = (LAS unsigned char*)lds_raw;
    cg::grid_group grid = cg::this_grid();
    volatile LAS unsigned* MISC = (volatile LAS unsigned*)(lds + LDS_BYTES - 64);
    if (threadIdx.x < 16) MISC[threadIdx.x] = 0u;
    __syncthreads();
    XcdBarrier xbar = xcd_barrier_post((unsigned*)a.ws, MISC + 8);
    if (a.ph_hi < 0) grid.sync();
    unsigned char* ws = a.ws; const int G = gridDim.x, bx = blockIdx.x;
    const int lo = a.ph_lo, hi = a.ph_hi;
    float* mods = (float*)(ws + WS_MODS); float* xo = a.out;
    bf16* H = (bf16*)(ws + WS_H); bf16* H2 = (bf16*)((unsigned char*)a.out + 128 * MiB); bf16* QKV = (bf16*)(ws + WS_BIG); bf16* ACT = (bf16*)(ws + WS_BIG);
    bf16* OC = (bf16*)a.out; bf16* QB = (bf16*)(ws + WS_QB); bf16* KV = (bf16*)(ws + WS_KV);
    bf16* XB = (bf16*)(ws + WS_XB);
    float* LSE = (float*)(ws + WS_LSE); float* LOGF = (float*)(ws + WS_LOGF); float* FB = (float*)(ws + WS_FB); const float* ROPE = (const float*)(ws + WS_ROPE);
#define IN(k) (lo <= (k) && (k) < hi)
#define SEAM(k) do { if (IN(k) && IN((k) + 1)) xcd_barrier(xbar); } while (0)
#define GEMM(EPI, Aptr, Bptr, N_, K_, E) GEMMR(EPI, Aptr, Bptr, N_, K_, E, 1)
#define GEMMR(EPI, Aptr, Bptr, N_, K_, E, R_) do { pg8::Gemm g_{(const pg8::bf16_t*)(Aptr), (const pg8::bf16_t*)(Bptr), M, (N_), (K_)}; pg8::StaticOrder S_; S_.init(M, (N_), G, bx); S_.rep = (R_); \
        pg8::gemm_phase<EPI, pg8::StaticOrder, true, true>(lds, g_, S_, E); } while (0)
#define NREP(k) ((PROBE_DUP == (k)) ? 1 + (a.ph_hi > 0) : 1)
    float* RSS = (float*)(ws + WS_RSS); const float* SW = (const float*)(ws + WS_SW);
    if (IN(0)) { phase_prologue(a, lds); } SEAM(0);
    if (IN(1)) { phase_norm<false>(a.in[I_X], a.in[I_GNA], mods + 0, mods + 2048, H, nullptr, nullptr, nullptr, nullptr); phase_sw(a); } SEAM(1);
    if (IN(2)) { EpiQKV E{QKV, NQKV, 1 << 30, nullptr, nullptr, 24, a.in[I_GQKA], 3, ROPE, nullptr, nullptr, 0}; GEMMR(EpiQKV, H, ws + WS_WQKV, NQKV, DM, E, NREP(30)); } SEAM(2);
    if (IN(3)) {
_Pragma("nounroll")
        for (int rep = 0; rep < NREP(40); ++rep) phase_attn_a(QKV, LSE, lds, rep + 1 < NREP(40)); } SEAM(3);
    if (IN(4)) { phase_combine(QKV, LSE, OC); } SEAM(4);
    if (IN(5)) { EpiR5 E{a.in[I_X], XB, DM, mods + 4096, MODS_LD, RSS, a.in[I_GNF], mods + 8192, H, nullptr, nullptr, nullptr}; GEMMR(EpiR5, OC, ws + WS_WOA, DM, WA, E, NREP(33)); } SEAM(5);
    if (IN(6)) { pg8::EpiSwiglu E{ACT, DFF, RSS, SW + SW_OFF0, NFFN}; GEMMR(pg8::EpiSwiglu, H, ws + WS_WFI, NFFN, DM, E, NREP(8)); } SEAM(6);
    if (IN(7)) { EpiR7 E{XB, XB, DM, mods + 10240, MODS_LD, RSS + M, a.in[I_GNKV], mods + 24576 + 2048, H, a.in[I_GNA] + DM, mods + 12288 + 2048, H2}; GEMMR(EpiR7, ACT, ws + WS_WFO, DM, DFF, E, NREP(31)); } SEAM(7);
    if (IN(8)) { { EpiKVQ E{KV, NKV, 16, LOGF, a.in[I_BF], 8, a.in[I_GKB], 31, nullptr, RSS + M, SW + SW_OFF1, NKVF}; GEMMR(EpiKVQ, H, ws + WS_WKV, NKVF, DM, E, NREP(32)); }
                 { EpiKVQ E{QB, DM, 1 << 30, nullptr, nullptr, 8, a.in[I_GQB], 31, nullptr, RSS + M, SW + SW_OFF2, DM}; GEMMR(EpiKVQ, H2, ws + WS_WQB, DM, DM, E, NREP(32)); } } SEAM(8);
    if (IN(9)) {
_Pragma("nounroll")
        for (int rep = 0; rep < NREP(41); ++rep) phase_attn_b(QB, KV, LOGF, a.in[I_BF], lds, rep + 1 < NREP(41)); } SEAM(9);
    if (IN(10)) { EpiR10 E{XB, XB, DM, mods + 12288 + 4096, MODS_LD, RSS + 2 * M, a.in[I_GNF] + DM, mods + 12288 + 8192, H, nullptr, nullptr, nullptr}; GEMMR(EpiR10, QB, ws + WS_WOB, DM, DM, E, NREP(33)); } SEAM(10);
    if (IN(11)) { pg8::EpiSwiglu E{ACT, DFF, RSS + 2 * M, SW + SW_OFF3, NFFN}; GEMM(pg8::EpiSwiglu, H, (bf16*)(ws + WS_WFI) + (size_t)NFFN * DM, NFFN, DM, E); } SEAM(11);
    if (IN(12)) { EpiR12 E{XB, xo, DM, mods + 12288 + 10240, MODS_LD, nullptr, nullptr, nullptr, nullptr, nullptr, nullptr, nullptr}; GEMMR(EpiR12, ACT, (bf16*)(ws + WS_WFO) + (size_t)DM * DFF, DM, DFF, E, NREP(31)); }
#undef IN
#undef SEAM
#undef GEMM
#undef GEMMR
}

extern "C" void kernel_launch(void* const* d_in, const int* in_sizes, int n_in, void* d_out, int out_size, void* d_ws, size_t ws_size, hipStream_t stream) {
    static int grid = 0;
    if (grid == 0) {
        if (n_in != 21 || in_sizes[0] != M * DM || out_size != M * DM || ws_size < WS_END) { fprintf(stderr, "kernel_launch: unexpected shapes (n_in %d, in0 %d, out %d, ws %zu)\n", n_in, n_in > 0 ? in_sizes[0] : -1, out_size, ws_size); grid = -1; return; }
        int dev = 0, cus = 0, per_cu = 0;
        (void)hipGetDevice(&dev); (void)hipDeviceGetAttribute(&cus, hipDeviceAttributeMultiprocessorCount, dev);
        if (hipFuncSetAttribute((const void*)yoco_fwd, hipFuncAttributeMaxDynamicSharedMemorySize, LDS_BYTES) != hipSuccess) { fprintf(stderr, "kernel_launch: hipFuncSetAttribute failed\n"); grid = -1; return; }
        if (hipOccupancyMaxActiveBlocksPerMultiprocessor(&per_cu, (const void*)yoco_fwd, NWAVES * 64, LDS_BYTES) != hipSuccess || per_cu < 1) { fprintf(stderr, "kernel_launch: occupancy query says %d\n", per_cu); per_cu = 1; }
        (void)hipGetLastError();
        grid = cus > 0 ? cus : 256;
    }
    if (grid < 0) return;
    if (hipMemsetAsync(d_ws, 0, 16384, stream) != hipSuccess) { fprintf(stderr, "kernel_launch: memset failed\n"); return; }
    Args a{};
    for (int i = 0; i < 21; ++i) a.in[i] = (const float*)d_in[i];
    a.out = (float*)d_out; a.ws = (unsigned char*)d_ws;
#if MK_N_LAUNCHES == 1
    a.ph_lo = 0; a.ph_hi = NPHASE;
    void* args[] = {&a};
    hipError_t e = hipLaunchCooperativeKernel((const void*)yoco_fwd, dim3(grid), dim3(NWAVES * 64), args, LDS_BYTES, stream);
    if (e != hipSuccess) fprintf(stderr, "kernel_launch: cooperative launch failed: %s (grid %d)\n", hipGetErrorString(e), grid);
#else
    for (int p = 0; p < NPHASE; ++p) { a.ph_lo = p; a.ph_hi = p + 1; hipLaunchKernelGGL(yoco_fwd, dim3(grid), dim3(NWAVES * 64), LDS_BYTES, stream, a); }
#endif
}
```
